# Optimizing an MI355X kernel written in HIP

```python
import math
import jax, jax.numpy as jnp
from jax import lax
import numpy as np

D_MODEL = 2048
BATCH = 4
SEQ = 4096
DEPTH = 2

SB_HEADS = 8
SB_HEAD_DIM = 128
SB_WIDTH = SB_HEADS * SB_HEAD_DIM
HG_HEADS = 8
HG_DIM = 128
HG_WIDTH = HG_HEADS * HG_DIM
D_FF = 4 * D_MODEL
N_ADA = 6 * D_MODEL
Q_BLOCK = 128
HG_CHUNK = 32
EPS = 1e-6
IN_SIZES = [SB_WIDTH] * 3 + [HG_WIDTH] * 4 + [D_MODEL] * 2
N_IN = sum(IN_SIZES)
IN_SPLITS = [int(v) for v in np.cumsum(IN_SIZES)[:-1]]

kernel_name = "hybrid_stickbreak_hgrn2_adaln_block"


def rmsnorm(x, g):
    xf = x.astype(jnp.float32)
    y = xf * lax.rsqrt(jnp.mean(xf * xf, axis=-1, keepdims=True) + EPS)
    return (y * g.astype(jnp.float32)).astype(x.dtype)


def modulate(h, shift, scale):
    return h * (1.0 + scale[:, None, :]) + shift[:, None, :]


def stick_breaking_attention(q, k, v):
    B, T, H, d = q.shape
    nblk = T // Q_BLOCK
    qf = q.astype(jnp.float32).transpose(0, 2, 1, 3)
    kf = k.astype(jnp.float32).transpose(0, 2, 1, 3)
    vf = v.astype(jnp.float32).transpose(0, 2, 1, 3)
    q_blocks = qf.reshape(B, H, nblk, Q_BLOCK, d).transpose(2, 0, 1, 3, 4)
    starts = jnp.arange(nblk, dtype=jnp.int32) * Q_BLOCK
    scale = 1.0 / math.sqrt(d)
    spos = jnp.arange(T, dtype=jnp.int32)[None, :]

    def block(args):
        qb, start = args
        z = jnp.einsum('bhqd,bhkd->bhqk', qb, kf) * scale
        tpos = start + jnp.arange(Q_BLOCK, dtype=jnp.int32)[:, None]
        causal = spos < tpos
        log_not = jnp.where(causal, jax.nn.log_sigmoid(-z), 0.0)
        rest = lax.cumsum(log_not, axis=3, reverse=True) - log_not
        a = jnp.where(causal, jnp.exp(jax.nn.log_sigmoid(z) + rest), 0.0)
        return jnp.einsum('bhqk,bhkd->bhqd', a, vf)

    out = lax.map(block, (q_blocks, starts))
    return out.transpose(1, 0, 3, 2, 4).reshape(B, T, H * d)


def hgrn2_recurrence(q, k, v, logf):
    B, T, H, dk = q.shape
    dv = v.shape[-1]
    C = HG_CHUNK
    N = T // C

    def chunks(a):
        return a.reshape(B, N, C, H, a.shape[-1]).transpose(1, 0, 3, 2, 4)

    q, k, v, logf = chunks(q), chunks(k), chunks(v), chunks(logf)
    G = jnp.cumsum(logf, axis=3)
    G_last = G[:, :, :, -1:, :]
    qg = q * jnp.exp(G)
    kg = k * jnp.exp(-G)
    kdec = k * jnp.exp(G_last - G)
    causal = jnp.tril(jnp.ones((C, C), dtype=bool))
    scores = jnp.where(causal, jnp.einsum('nbhtd,nbhsd->nbhts', qg, kg), 0.0)
    o_intra = jnp.einsum('nbhts,nbhse->nbhte', scores, v)
    state_in = jnp.einsum('nbhsd,nbhse->nbhde', kdec, v)
    decay = jnp.exp(G_last[:, :, :, 0, :])

    def step(S, inp):
        dec, ds = inp
        return dec[..., None] * S + ds, S

    S0 = jnp.zeros((B, H, dk, dv), jnp.float32)
    _, S_prev = lax.scan(step, S0, (decay, state_in))
    o_inter = jnp.einsum('nbhtd,nbhde->nbhte', qg, S_prev)
    o = o_intra + o_inter
    return o.transpose(1, 0, 3, 2, 4).reshape(B, T, H, dv)


def setup_inputs(seed: int = 0) -> dict:
    key = jax.random.key(seed)
    ks = jax.random.split(key, 16)
    L, D = DEPTH, D_MODEL

    def w(k, shape, fan_in, mult=1.0):
        return jax.random.normal(k, shape, jnp.float32) * (mult * fan_in ** -0.5)

    def gain(k, shape):
        return 1.0 + 0.05 * jax.random.normal(k, shape, jnp.float32)

    return {
        "x": jax.random.normal(ks[0], (BATCH, SEQ, D), jnp.float32),
        "c": jax.random.normal(ks[1], (BATCH, D), jnp.float32),
        "w_ada": w(ks[2], (L, D, N_ADA), D, 0.5),
        "b_ada": 0.01 * jax.random.normal(ks[3], (L, N_ADA), jnp.float32),
        "g_pre_mix": gain(ks[4], (L, D)),
        "g_post_mix": gain(ks[5], (L, D)),
        "w_in": w(ks[6], (L, D, N_IN), D),
        "hg_lb_logits": 0.5 * jax.random.normal(ks[7], (L, HG_WIDTH), jnp.float32),
        "g_hg_norm": gain(ks[8], (L, HG_WIDTH)),
        "w_proj_sb": w(ks[9], (L, SB_WIDTH, D), SB_WIDTH),
        "w_proj_hg": w(ks[10], (L, HG_WIDTH, D), HG_WIDTH),
        "w_out": w(ks[11], (L, D, D), D),
        "g_pre_mlp": gain(ks[12], (L, D)),
        "g_post_mlp": gain(ks[13], (L, D)),
        "w_mlp_up": w(ks[14], (L, D, D_FF), D),
        "w_mlp_down": w(ks[15], (L, D_FF, D), D_FF),
    }


def reference(x, c, w_ada, b_ada, g_pre_mix, g_post_mix, w_in, hg_lb_logits,
              g_hg_norm, w_proj_sb, w_proj_hg, w_out, g_pre_mlp, g_post_mlp,
              w_mlp_up, w_mlp_down):
    B, T, _ = x.shape
    dt = x.dtype
    lbs = jnp.cumsum(jax.nn.softmax(hg_lb_logits.astype(jnp.float32), axis=0), axis=0)
    lbs = lbs - lbs[0:1]
    c_act = jax.nn.silu(c)
    for l in range(DEPTH):
        cond = c_act @ w_ada[l] + b_ada[l]
        sh1, sc1, gt1, sh2, sc2, gt2 = jnp.split(cond, 6, axis=-1)

        h = modulate(rmsnorm(x, g_pre_mix[l]), sh1, sc1)
        p = h @ w_in[l]
        sq, sk, sv, hq, hf, hi, hg, ga, gb = jnp.split(p, IN_SPLITS, axis=-1)

        def heads_sb(a):
            return a.reshape(B, T, SB_HEADS, SB_HEAD_DIM)

        y_sb = stick_breaking_attention(heads_sb(sq), heads_sb(sk), heads_sb(sv)).astype(dt)

        lb = lbs[l]
        hf32 = hf.astype(jnp.float32)
        logf = jnp.logaddexp(jnp.log(lb), jnp.log1p(-lb) + jax.nn.log_sigmoid(hf32))
        kk = (1.0 - lb) * jax.nn.sigmoid(-hf32)
        qq = jax.nn.silu(hq.astype(jnp.float32))

        def heads_hg(a):
            return a.reshape(B, T, HG_HEADS, HG_DIM)

        o = hgrn2_recurrence(heads_hg(qq), heads_hg(kk), heads_hg(hi.astype(jnp.float32)),
                             heads_hg(logf))
        o = rmsnorm(o, g_hg_norm[l].reshape(HG_HEADS, HG_DIM))
        o = o * jax.nn.silu(heads_hg(hg.astype(jnp.float32)))
        y_hg = o.reshape(B, T, HG_WIDTH).astype(dt)

        merged = jax.nn.sigmoid(ga) * (y_sb @ w_proj_sb[l]) + jax.nn.sigmoid(gb) * (y_hg @ w_proj_hg[l])
        mix_out = merged @ w_out[l]
        x = x + gt1[:, None, :] * rmsnorm(mix_out, g_post_mix[l])

        h2 = modulate(rmsnorm(x, g_pre_mlp[l]), sh2, sc2)
        u = jnp.square(jax.nn.relu(h2 @ w_mlp_up[l]))
        mlp_out = u @ w_mlp_down[l]
        x = x + gt2[:, None, :] * rmsnorm(mlp_out, g_post_mlp[l])
    return x
```

```cpp
#include <hip/hip_runtime.h>
#include <hip/hip_cooperative_groups.h>
#include <cstdio>
namespace cg = cooperative_groups;

namespace pg8 {
#define PG8_LAS __attribute__((address_space(3)))
typedef unsigned short bf16_t;
typedef short bf16x8 __attribute__((ext_vector_type(8)));
typedef float f32x4 __attribute__((ext_vector_type(4)));
typedef unsigned u32x4 __attribute__((ext_vector_type(4)));
constexpr int BM = 256, BK = 64, HALF = 128, HTB = HALF * BK * 2  , STAGE_BYTES = 8 * HTB, NXCD = 8, WGM = 8;

__host__ __device__ __forceinline__ int lds_byte(int r, int c) { const int st = (r >> 4) * 2 + (c >> 5), rr = r & 15, cc = c & 31, ob = rr * 64 + cc * 2; return st * 1024 + (ob ^ (((ob >> 9) & 1) << 5)); }
__host__ __device__ __forceinline__ void stage_rc(int b, int& R, int& C) { const int st = b / 1024, sb = b % 1024, swz = sb ^ (((sb >> 9) & 1) << 5); R = (st >> 1) * 16 + swz / 64; C = (st & 1) * 32 + (swz % 64) / 2; }
__host__ __device__ __forceinline__ int perm32(int rho) { const int n = rho >> 4, i = rho & 15; return 8 * (i >> 2) + 4 * n + (i & 3); }

struct Unit { int pm, pn; };
struct Gemm { const bf16_t* A; const bf16_t* Bt; int M, N, K; };

struct StaticOrder {
    int nM, nN, nwg, G, c;
    __host__ __device__ void init(int M, int N, int G_, int c_) { nM = M / BM; nN = N / BM; nwg = nM * nN; G = G_; c = c_; }
    __host__ __device__ bool next(int i, Unit& u) const {
        const long L = (long)i * G + c; if (L >= nwg) return false;
        int wgid = (int)L; { const int q = nwg / NXCD, r = nwg % NXCD, xcd = wgid % NXCD, off = wgid / NXCD; wgid = (xcd < r ? xcd * (q + 1) : r * (q + 1) + (xcd - r) * q) + off; }
        const int nig = WGM * nN, gid = wgid / nig, fm = gid * WGM, gsz = (nM - fm) < WGM ? (nM - fm) : WGM;
        u.pm = fm + ((wgid % nig) % gsz); u.pn = (wgid % nig) / gsz; return true;
    }
    __device__ __forceinline__ void a_ready(const Unit&) const {}
    __device__ __forceinline__ void done(const Unit&) const {}
};
__device__ __forceinline__ unsigned cvt_pk_bf16(float lo, float hi) { unsigned r; asm volatile("v_cvt_pk_bf16_f32 %0, %1, %2" : "=v"(r) : "v"(lo), "v"(hi)); return r; }
template <class Epi, class Sched, bool STAMP = false>
__device__ __forceinline__ void gemm_phase(PG8_LAS unsigned char* lds, const Gemm g, const Sched& S, const Epi& E, unsigned long long* stamps) {
    int tid_l = threadIdx.x; asm volatile("" : "+v"(tid_l));
    const int tid = tid_l, wid = __builtin_amdgcn_readfirstlane(tid >> 6), lane = tid & 63, wr = wid >> 2, wc = wid & 3, fr = lane & 15, fq = lane >> 4;
    const int K = g.K, nt = K / BK;
    int ts_lo = 0, ts_hi = 0, nts = 0; const unsigned long long rt_entry = STAMP ? (unsigned long long)wall_clock64() : 0ull;
#define PG8_STAMP() do { if (STAMP && wid == 0 && nts < 64) { const unsigned long long _c = (unsigned long long)clock64(); \
        ts_lo = (lane == nts) ? (int)(unsigned)_c : ts_lo; ts_hi = (lane == nts) ? (int)(unsigned)(_c >> 32) : ts_hi; ++nts; } } while (0)
    PG8_STAMP();
    unsigned voffA[2], voffB[2];
#pragma unroll
    for (int i = 0; i < 2; ++i) { int R, C; stage_rc(tid * 16 + i * 8192, R, C); const int Rb = Epi::PERM ? ((R & ~31) + perm32(R & 31)) : R;
        voffA[i] = (unsigned)(R * K + C) * 2u; voffB[i] = (unsigned)(Rb * K + C) * 2u; }
    const size_t kstep = (size_t)(BK * 2);
    const size_t hstep = (size_t)HALF * K * 2;
    const size_t tstep = 2 * hstep;
    const unsigned ldsw = (unsigned)wid * 1024u;
    const int aoff = lds_byte(wr * 64 + fr, fq * 8), boff = lds_byte(wc * 32 + fr, fq * 8);
#define PG8_SA(b, h) (((b) * 2 + (h)) * HTB)
#define PG8_SB(b, h) ((4 + (b) * 2 + (h)) * HTB)
#define PG8_STAGE(bufoff, gbase, voff) do { _Pragma("unroll") for (int _i = 0; _i < 2; ++_i) \
        __builtin_amdgcn_global_load_lds((const unsigned*)((const char*)(gbase) + (voff)[_i]), (PG8_LAS unsigned*)(lds + (bufoff) + ldsw + _i * 8192), 16, 0, 0); } while (0)
#define PG8_LDA(dst, b, h) do { _Pragma("unroll") for (int m = 0; m < 4; ++m) _Pragma("unroll") for (int k = 0; k < 2; ++k) dst[m][k] = *(const PG8_LAS bf16x8*)(lds + PG8_SA(b, h) + aoff + m * 2048 + k * 1024); } while (0)
#define PG8_LDB(dst, b, h) do { _Pragma("unroll") for (int n = 0; n < 2; ++n) _Pragma("unroll") for (int k = 0; k < 2; ++k) dst[n][k] = *(const PG8_LAS bf16x8*)(lds + PG8_SB(b, h) + boff + n * 2048 + k * 1024); } while (0)
#define PG8_MMA(ai, bj, At, Bt) do { __builtin_amdgcn_s_setprio(1); _Pragma("unroll") for (int m = 0; m < 4; ++m) _Pragma("unroll") for (int n = 0; n < 2; ++n) _Pragma("unroll") for (int k = 0; k < 2; ++k) \
        acc[ai][bj][m][n] = __builtin_amdgcn_mfma_f32_16x16x32_bf16(Bt[n][k], At[m][k], acc[ai][bj][m][n], 0, 0, 0); __builtin_amdgcn_s_setprio(0); } while (0)
#define PG8_WAIT_V(n) asm volatile("s_waitcnt vmcnt(" #n ")" ::: "memory")
#define PG8_WAIT_L(n) asm volatile("s_waitcnt lgkmcnt(" #n ")" ::: "memory")
#define PG8_BAR __builtin_amdgcn_s_barrier()
#define PG8_SCHED __builtin_amdgcn_sched_barrier(0)
    Unit cur, nxt; int ui = 0;
    if (!S.next(0, cur)) return;
    f32x4 acc[2][2][4][2];
#pragma unroll
    for (int a = 0; a < 2; ++a)
#pragma unroll
        for (int b = 0; b < 2; ++b)
#pragma unroll
            for (int m = 0; m < 4; ++m)
#pragma unroll
                for (int n = 0; n < 2; ++n) acc[a][b][m][n] = (f32x4){0.f, 0.f, 0.f, 0.f};
    bf16x8 At[4][2], B0[2][2], B1[2][2];
    const char* cA = (const char*)g.A + (size_t)cur.pm * tstep; const char* cB = (const char*)g.Bt + (size_t)cur.pn * tstep;
    S.a_ready(cur);
    PG8_STAGE(PG8_SB(0, 0), cB, voffB); PG8_STAGE(PG8_SA(0, 0), cA, voffA); PG8_STAGE(PG8_SB(0, 1), cB + hstep, voffB); PG8_STAGE(PG8_SA(0, 1), cA + hstep, voffA);
    if (wr == 1) PG8_BAR;
    PG8_WAIT_V(4); PG8_BAR;
    PG8_STAGE(PG8_SB(1, 0), cB + kstep, voffB); PG8_STAGE(PG8_SA(1, 0), cA + kstep, voffA); PG8_STAGE(PG8_SB(1, 1), cB + hstep + kstep, voffB);
    PG8_WAIT_V(6); PG8_BAR;
    PG8_STAMP();
    for (;;) {
        const bool has_next = S.next(ui + 1, nxt);
        const char* nA = has_next ? (const char*)g.A + (size_t)nxt.pm * tstep : cA; const char* nB = has_next ? (const char*)g.Bt + (size_t)nxt.pn * tstep : cB;
        for (int t = 0; t < nt; t += 2) {
            const bool last = (t == nt - 2);
            const char* a1 = cA + (size_t)(t + 1) * kstep;
            const char* a2 = last ? nA : cA + (size_t)(t + 2) * kstep; const char* b2 = last ? nB : cB + (size_t)(t + 2) * kstep;
            const char* a3 = a2 + kstep; const char* b3 = b2 + kstep;
            if (last && has_next) S.a_ready(nxt);
            PG8_LDB(B0, 0, 0); PG8_SCHED; PG8_LDA(At, 0, 0); PG8_STAGE(PG8_SA(1, 1), a1 + hstep, voffA);
            PG8_WAIT_L(8); PG8_BAR; PG8_WAIT_L(0); PG8_MMA(0, 0, At, B0); PG8_BAR; PG8_SCHED;
            PG8_LDB(B1, 0, 1); PG8_STAGE(PG8_SB(0, 0), b2, voffB);
            PG8_BAR; PG8_WAIT_L(0); PG8_MMA(0, 1, At, B1); PG8_BAR;
            PG8_LDA(At, 0, 1); PG8_STAGE(PG8_SA(0, 0), a2, voffA);
            PG8_BAR; PG8_WAIT_L(0); PG8_MMA(1, 0, At, B0); PG8_BAR; PG8_SCHED;
            PG8_STAGE(PG8_SB(0, 1), b2 + hstep, voffB);
            PG8_WAIT_V(6); PG8_BAR; PG8_MMA(1, 1, At, B1); PG8_BAR;
            PG8_LDB(B0, 1, 0); PG8_SCHED; PG8_LDA(At, 1, 0); PG8_STAGE(PG8_SA(0, 1), a2 + hstep, voffA);
            PG8_WAIT_L(8); PG8_BAR; PG8_WAIT_L(0); PG8_MMA(0, 0, At, B0); PG8_BAR; PG8_SCHED;
            PG8_LDB(B1, 1, 1); PG8_STAGE(PG8_SB(1, 0), b3, voffB);
            PG8_BAR; PG8_WAIT_L(0); PG8_MMA(0, 1, At, B1); PG8_BAR;
            PG8_LDA(At, 1, 1); PG8_STAGE(PG8_SA(1, 0), a3, voffA);
            PG8_BAR; PG8_WAIT_L(0); PG8_MMA(1, 0, At, B0); PG8_BAR; PG8_SCHED;
            PG8_STAGE(PG8_SB(1, 1), b3 + hstep, voffB);
            PG8_WAIT_V(6); PG8_BAR; PG8_MMA(1, 1, At, B1); PG8_BAR;
        }
        PG8_STAMP();
        if constexpr (!Epi::AFTER_DRAIN) { E(acc, cur, wr, wc, fr, fq); S.done(cur); }
        PG8_STAMP();
        if (!has_next) break;
#pragma unroll
        for (int a = 0; a < 2; ++a)
#pragma unroll
            for (int b = 0; b < 2; ++b)
#pragma unroll
                for (int m = 0; m < 4; ++m)
#pragma unroll
                    for (int n = 0; n < 2; ++n) acc[a][b][m][n] = (f32x4){0.f, 0.f, 0.f, 0.f};
        cur = nxt; cA = nA; cB = nB; ++ui;
    }
    PG8_WAIT_V(0);
    if (wr == 0) PG8_BAR;
    PG8_BAR;
    if constexpr (Epi::AFTER_DRAIN) { E.fused(acc, cur, wr, wc, fr, fq, lds, wid, lane); S.done(cur); }
    PG8_STAMP();
    if (STAMP && wid == 0) { stamps[lane] = lane < nts ? (((unsigned long long)(unsigned)ts_hi << 32) | (unsigned)ts_lo) : 0ull;
        if (lane == 62) stamps[62] = rt_entry; if (lane == 63) stamps[63] = (unsigned long long)wall_clock64(); }
#undef PG8_STAMP
#undef PG8_SA
#undef PG8_SB
#undef PG8_STAGE
#undef PG8_LDA
#undef PG8_LDB
#undef PG8_MMA
#undef PG8_WAIT_V
#undef PG8_WAIT_L
#undef PG8_BAR
#undef PG8_SCHED
}
}

using pg8::bf16_t; using pg8::bf16x8; using pg8::f32x4; using pg8::u32x4;
typedef float f32x16 __attribute__((ext_vector_type(16)));
typedef float f32x2 __attribute__((ext_vector_type(2)));
typedef unsigned u32x2 __attribute__((ext_vector_type(2)));
typedef __bf16 bf2_t __attribute__((ext_vector_type(2)));
#define LAS PG8_LAS
#define MFMA32(a, b, c) __builtin_amdgcn_mfma_f32_32x32x16_bf16((a), (b), (c), 0, 0, 0)

constexpr int D = 2048, NB = 4, T = 4096, M = NB * T, FF = 8192, NADA = 6 * D;
constexpr int NG1 = 7168, NG2 = 4096;
constexpr float EPS = 1e-6f;
constexpr int NTHR = 512, LDS_BYTES = 131072;
constexpr size_t MiB = (size_t)1 << 20;
constexpr size_t W_IN = 0, W_SB = 23068672, W_HG = W_SB + 2097152, W_OUT = W_HG + 2097152, W_UP = W_OUT + 4194304, W_DN = W_UP + 16777216;
constexpr size_t WS_W = 0, WS_HB = 124 * MiB, WS_R1 = 188 * MiB, WS_R2 = 444 * MiB, WS_R3 = 508 * MiB, WS_R4 = 636 * MiB, WS_R5 = 668 * MiB, WS_SM = 796 * MiB;
constexpr size_t WS_PART = WS_SM, WS_COND = WS_SM + 3 * MiB, WS_LB = WS_COND + 393216, WS_DEC = WS_SM + 4 * MiB, WS_END = WS_SM + 6 * MiB;
constexpr size_t R1_Q = WS_R1, R1_K = WS_R1 + 32 * MiB, R1_VT = WS_R1 + 64 * MiB, R1_QQT = WS_R1 + 96 * MiB, R1_KKT = WS_R1 + 128 * MiB, R1_VHT = WS_R1 + 160 * MiB, R1_LOGFT = WS_R1 + 192 * MiB;
constexpr size_t R1_PBUF = WS_R1, R1_U = WS_R1;
constexpr size_t R2_QG = WS_R2, R2_KG = WS_R2 + 32 * MiB, R2_MERGED = WS_R2;
constexpr size_t R3_ST = WS_R3, R3_MIX = WS_R3;
constexpr size_t R4_SHG = WS_R4, R5_SGA = WS_R5, R5_SGB = WS_R5 + 64 * MiB;
constexpr size_t HB_YSB = WS_HB, HB_YHG = WS_HB + 32 * MiB;

struct Params {
    const float* x; const float* c; const float* w_ada; const float* b_ada; const float* g_pre_mix; const float* g_post_mix; const float* w_in; const float* lb_logits;
    const float* g_hg; const float* w_sb; const float* w_hg; const float* w_out; const float* g_pre_mlp; const float* g_post_mlp; const float* w_up; const float* w_dn;
    float* out; unsigned char* ws;
};

__device__ __forceinline__ unsigned pk2(float a, float b) { f32x2 v = {a, b}; bf2_t r = __builtin_convertvector(v, bf2_t); return __builtin_bit_cast(unsigned, r); }
__device__ __forceinline__ float bflo(unsigned w) { return __uint_as_float(w << 16); }
__device__ __forceinline__ float bfhi(unsigned w) { return __uint_as_float(w & 0xffff0000u); }
__device__ __forceinline__ float sigm(float x) { return 1.f / (1.f + __expf(-x)); }
__device__ __forceinline__ float silu_(float x) { return x / (1.f + __expf(-x)); }
__device__ __forceinline__ int ltid() { int t = threadIdx.x; asm volatile("" : "+v"(t)); return t; }
__device__ __forceinline__ f32x16 zero16() { f32x16 z; _Pragma("unroll") for (int i = 0; i < 16; ++i) z[i] = 0.f; return z; }

template <int MODE> struct Epi {
    static constexpr bool PERM = true, AFTER_DRAIN = false;
    unsigned char* ws; const float* lb;
    __device__ __forceinline__ void operator()(const f32x4 (&acc)[2][2][4][2], const pg8::Unit& u, int wr, int wc, int fr, int fq) const {
        const int row0 = u.pm * 256 + wr * 64 + fr, col0 = u.pn * 256 + wc * 32 + 8 * fq;
        bf16_t* base1 = nullptr; int ld1 = 1024, act1 = 0, cb1 = 0;
        if (MODE == 1) { const int ct = u.pn * 256;
            if (ct < 1024) { base1 = (bf16_t*)(ws + R1_Q); }
            else if (ct < 2048) { base1 = (bf16_t*)(ws + R1_K); cb1 = 1024; }
            else if (ct < 3072) { base1 = (bf16_t*)(ws + R4_SHG); cb1 = 2048; act1 = 1; }
            else if (ct < 5120) { base1 = (bf16_t*)(ws + R5_SGA); cb1 = 3072; act1 = 2; ld1 = 2048; }
            else { base1 = (bf16_t*)(ws + R5_SGB); cb1 = 5120; act1 = 2; ld1 = 2048; } }
        const int rt2 = u.pm * 256;
#pragma unroll
        for (int ai = 0; ai < 2; ++ai)
#pragma unroll
            for (int m = 0; m < 4; ++m) { const int row = row0 + ai * 128 + m * 16;
                float lbv = 0.f; if (MODE == 2) { if (rt2 >= 2048 && rt2 < 3072) lbv = lb[row - 2048]; }
#pragma unroll
                for (int bj = 0; bj < 2; ++bj) { const int col = col0 + bj * 128; const f32x4 v0 = acc[ai][bj][m][0], v1 = acc[ai][bj][m][1];
                    float v[8] = {v0[0], v0[1], v0[2], v0[3], v1[0], v1[1], v1[2], v1[3]};
                    if (MODE == 1) {
                        if (act1 == 1) { _Pragma("unroll") for (int j = 0; j < 8; ++j) v[j] = silu_(v[j]); }
                        else if (act1 == 2) { _Pragma("unroll") for (int j = 0; j < 8; ++j) v[j] = sigm(v[j]); }
                        u32x4 w; w.x = pk2(v[0], v[1]); w.y = pk2(v[2], v[3]); w.z = pk2(v[4], v[5]); w.w = pk2(v[6], v[7]);
                        *(u32x4*)(base1 + (size_t)row * ld1 + (col - cb1)) = w;
                    } else if (MODE == 2) {
                        if (rt2 >= 2048 && rt2 < 3072) {
                            float lg[8], kk[8];
                            _Pragma("unroll") for (int j = 0; j < 8; ++j) { const float xx = v[j]; const float ls = fminf(xx, 0.f) - __logf(1.f + __expf(-fabsf(xx)));
                                lg[j] = (lbv > 0.f) ? __logf(lbv + (1.f - lbv) * __expf(ls)) : ls; kk[j] = (1.f - lbv) * __expf(ls - xx); }
                            float* lp = (float*)(ws + R1_LOGFT) + (size_t)(row - 2048) * M + col;
                            *(f32x4*)lp = (f32x4){lg[0], lg[1], lg[2], lg[3]}; *(f32x4*)(lp + 4) = (f32x4){lg[4], lg[5], lg[6], lg[7]};
                            u32x4 w; w.x = pk2(kk[0], kk[1]); w.y = pk2(kk[2], kk[3]); w.z = pk2(kk[4], kk[5]); w.w = pk2(kk[6], kk[7]);
                            *(u32x4*)((bf16_t*)(ws + R1_KKT) + (size_t)(row - 2048) * M + col) = w;
                        } else {
                            bf16_t* b2; int rb;
                            if (rt2 < 1024) { b2 = (bf16_t*)(ws + R1_VT); rb = 0; } else if (rt2 < 2048) { b2 = (bf16_t*)(ws + R1_QQT); rb = 1024; _Pragma("unroll") for (int j = 0; j < 8; ++j) v[j] = silu_(v[j]); }
                            else { b2 = (bf16_t*)(ws + R1_VHT); rb = 3072; }
                            u32x4 w; w.x = pk2(v[0], v[1]); w.y = pk2(v[2], v[3]); w.z = pk2(v[4], v[5]); w.w = pk2(v[6], v[7]);
                            *(u32x4*)(b2 + (size_t)(row - rb) * M + col) = w;
                        }
                    } else if (MODE == 3) {
                        const u32x4 g = *(const u32x4*)((const bf16_t*)(ws + R5_SGA) + (size_t)row * D + col);
                        float* pp = (float*)(ws + R1_PBUF) + (size_t)row * D + col;
                        *(f32x4*)pp = (f32x4){v[0] * bflo(g.x), v[1] * bfhi(g.x), v[2] * bflo(g.y), v[3] * bfhi(g.y)};
                        *(f32x4*)(pp + 4) = (f32x4){v[4] * bflo(g.z), v[5] * bfhi(g.z), v[6] * bflo(g.w), v[7] * bfhi(g.w)};
                    } else if (MODE == 4) {
                        const u32x4 g = *(const u32x4*)((const bf16_t*)(ws + R5_SGB) + (size_t)row * D + col);
                        const float* pp = (const float*)(ws + R1_PBUF) + (size_t)row * D + col;
                        const f32x4 p0 = *(const f32x4*)pp, p1 = *(const f32x4*)(pp + 4);
                        u32x4 w; w.x = pk2(p0[0] + v[0] * bflo(g.x), p0[1] + v[1] * bfhi(g.x)); w.y = pk2(p0[2] + v[2] * bflo(g.y), p0[3] + v[3] * bfhi(g.y));
                        w.z = pk2(p1[0] + v[4] * bflo(g.z), p1[1] + v[5] * bfhi(g.z)); w.w = pk2(p1[2] + v[6] * bflo(g.w), p1[3] + v[7] * bfhi(g.w));
                        *(u32x4*)((bf16_t*)(ws + R2_MERGED) + (size_t)row * D + col) = w;
                    } else if (MODE == 5) {
                        float* pp = (float*)(ws + R3_MIX) + (size_t)row * D + col;
                        *(f32x4*)pp = v0; *(f32x4*)(pp + 4) = v1;
                    } else if (MODE == 6) {
                        _Pragma("unroll") for (int j = 0; j < 8; ++j) { const float r = fmaxf(v[j], 0.f); v[j] = r * r; }
                        u32x4 w; w.x = pk2(v[0], v[1]); w.y = pk2(v[2], v[3]); w.z = pk2(v[4], v[5]); w.w = pk2(v[6], v[7]);
                        *(u32x4*)((bf16_t*)(ws + R1_U) + (size_t)row * FF + col) = w;
                    }
                } }
    }
};

template <int MODE> __device__ __forceinline__ void run_gemm(LAS unsigned char* lds, const bf16_t* A, const bf16_t* Bt, int M_, int N_, int K_, unsigned char* ws, const float* lb) {
    pg8::Gemm g{A, Bt, M_, N_, K_}; pg8::StaticOrder S; S.init(M_, N_, (int)gridDim.x, (int)blockIdx.x);
    Epi<MODE> E{ws, lb};
    pg8::gemm_phase<Epi<MODE>, pg8::StaticOrder, false>(lds, g, S, E, nullptr);
}

__device__ void prep_weights(const Params& p, int layer, float* tile) {
    const int tid = ltid();
    bf16_t* Wb = (bf16_t*)(p.ws + WS_W);
    for (int t = blockIdx.x; t < 15872; t += gridDim.x) {
        int tt = t; const float* src; bf16_t* dst; int K, N, remap = 0;
        if (tt < 5632) { src = p.w_in + (size_t)layer * 2048 * 11264; dst = Wb + W_IN; K = 2048; N = 11264; remap = 1; }
        else if ((tt -= 5632) < 512) { src = p.w_sb + (size_t)layer * 1024 * 2048; dst = Wb + W_SB; K = 1024; N = 2048; }
        else if ((tt -= 512) < 512) { src = p.w_hg + (size_t)layer * 1024 * 2048; dst = Wb + W_HG; K = 1024; N = 2048; }
        else if ((tt -= 512) < 1024) { src = p.w_out + (size_t)layer * 2048 * 2048; dst = Wb + W_OUT; K = 2048; N = 2048; }
        else if ((tt -= 1024) < 4096) { src = p.w_up + (size_t)layer * 2048 * 8192; dst = Wb + W_UP; K = 2048; N = 8192; }
        else { tt -= 4096; src = p.w_dn + (size_t)layer * 8192 * 2048; dst = Wb + W_DN; K = 8192; N = 2048; }
        const int nk = K / 64, tn = tt / nk, tk = tt % nk;
#pragma unroll
        for (int i = 0; i < 2; ++i) { const int idx = tid + i * 512, r = idx >> 4, c4 = (idx & 15) * 4;
            const f32x4 v = *(const f32x4*)(src + (size_t)(tk * 64 + r) * N + tn * 64 + c4);
            tile[r * 65 + c4] = v[0]; tile[r * 65 + c4 + 1] = v[1]; tile[r * 65 + c4 + 2] = v[2]; tile[r * 65 + c4 + 3] = v[3]; }
        __syncthreads();
        { const int n = tid >> 3, k8 = (tid & 7) * 8; float f[8];
#pragma unroll
            for (int j = 0; j < 8; ++j) f[j] = tile[(k8 + j) * 65 + n];
            int drow = tn * 64 + n;
            if (remap) { if (drow >= 6144) drow = 2048 + (drow - 6144); else if (drow >= 2048) drow = 7168 + (drow - 2048); }
            u32x4 w; w.x = pk2(f[0], f[1]); w.y = pk2(f[2], f[3]); w.z = pk2(f[4], f[5]); w.w = pk2(f[6], f[7]);
            *(u32x4*)(dst + (size_t)drow * K + tk * 64 + k8) = w; }
        __syncthreads();
    }
}

__device__ void ada_partials(const Params& p, float* sl) {
    const int tid = ltid(); float* part = (float*)(p.ws + WS_PART);
    for (int u = blockIdx.x; u < 384; u += gridDim.x) {
        const int jb = u % 24, s = (u / 24) % 8, l = u / 192;
        __syncthreads();
        for (int i = tid; i < 1024; i += NTHR) { const int b = i >> 8, k = i & 255; sl[i] = silu_(p.c[b * D + s * 256 + k]); }
        __syncthreads();
        const int j = jb * 512 + tid;
        const float* w = p.w_ada + ((size_t)l * D + s * 256) * NADA + j;
        float a0 = 0.f, a1 = 0.f, a2 = 0.f, a3 = 0.f;
#pragma unroll 8
        for (int k = 0; k < 256; ++k) { const float wv = w[(size_t)k * NADA]; a0 += wv * sl[k]; a1 += wv * sl[256 + k]; a2 += wv * sl[512 + k]; a3 += wv * sl[768 + k]; }
        float* po = part + (size_t)((s * 2 + l) * 4) * NADA + j;
        po[0] = a0; po[NADA] = a1; po[2 * NADA] = a2; po[3 * NADA] = a3;
    }
}

__device__ void cond_finalize(const Params& p) {
    const int gt = blockIdx.x * NTHR + ltid(), nt = gridDim.x * NTHR;
    const float* part = (const float*)(p.ws + WS_PART); float* cond = (float*)(p.ws + WS_COND); float* lb = (float*)(p.ws + WS_LB);
    for (int i = gt; i < 2 * 4 * NADA; i += nt) { const int l = i / (4 * NADA), rem = i % (4 * NADA), b = rem / NADA, j = rem % NADA;
        float a = p.b_ada[l * NADA + j];
#pragma unroll
        for (int s = 0; s < 8; ++s) a += part[(size_t)((s * 2 + l) * 4 + b) * NADA + j];
        cond[i] = a; }
    for (int i = gt; i < 2048; i += nt) { const int l = i >> 10, j = i & 1023;
        lb[i] = (l == 0) ? 0.f : 1.f / (1.f + __expf(p.lb_logits[j] - p.lb_logits[1024 + j])); }
}

template <int KIND> __device__ void rowpass(const float* xres, const float* mbuf, float* xout, bf16_t* hout, const float* gpost, const float* gt_, const float* gpre, const float* sc_, const float* sh_) {
    const int tid = ltid(), lane = tid & 63, wave = tid >> 6;
    const int nw = gridDim.x * 8;
    for (int row = blockIdx.x * 8 + wave; row < M; row += nw) {
        const int b = row >> 12; const size_t cb = (size_t)b * NADA;
        f32x4 v[8];
        if (KIND == 0) {
#pragma unroll
            for (int i = 0; i < 8; ++i) v[i] = *(const f32x4*)(xres + (size_t)row * D + 4 * lane + 256 * i);
        } else {
            float ss = 0.f;
#pragma unroll
            for (int i = 0; i < 8; ++i) { v[i] = *(const f32x4*)(mbuf + (size_t)row * D + 4 * lane + 256 * i); ss += v[i][0] * v[i][0] + v[i][1] * v[i][1] + v[i][2] * v[i][2] + v[i][3] * v[i][3]; }
#pragma unroll
            for (int o = 32; o >= 1; o >>= 1) ss += __shfl_xor(ss, o);
            const float rs = rsqrtf(ss * (1.f / D) + EPS);
#pragma unroll
            for (int i = 0; i < 8; ++i) { const int c = 4 * lane + 256 * i;
                const f32x4 xr = *(const f32x4*)(xres + (size_t)row * D + c), gp = *(const f32x4*)(gpost + c), gg = *(const f32x4*)(gt_ + cb + c);
                v[i] = xr + gg * (v[i] * rs * gp);
                *(f32x4*)(xout + (size_t)row * D + c) = v[i]; }
        }
        if (KIND != 2) {
            float ss = 0.f;
#pragma unroll
            for (int i = 0; i < 8; ++i) ss += v[i][0] * v[i][0] + v[i][1] * v[i][1] + v[i][2] * v[i][2] + v[i][3] * v[i][3];
#pragma unroll
            for (int o = 32; o >= 1; o >>= 1) ss += __shfl_xor(ss, o);
            const float rs = rsqrtf(ss * (1.f / D) + EPS);
#pragma unroll
            for (int i = 0; i < 8; ++i) { const int c = 4 * lane + 256 * i;
                const f32x4 gp = *(const f32x4*)(gpre + c), sc = *(const f32x4*)(sc_ + cb + c), sh = *(const f32x4*)(sh_ + cb + c);
                const f32x4 hh = (v[i] * rs * gp) * (1.f + sc) + sh;
                u32x2 w; w.x = pk2(hh[0], hh[1]); w.y = pk2(hh[2], hh[3]);
                *(u32x2*)(hout + (size_t)row * D + c) = w; }
        }
    }
}

__device__ __forceinline__ void attn_item(const bf16_t* Q, const bf16_t* Kb, const bf16_t* VT, bf16_t* Y, int item, int lane) {
    const int qt = 127 - (item & 127), hd = (item >> 7) & 7, b = item >> 10;
    const int tq = lane & 31, h = lane >> 5;
    const size_t tb = (size_t)b * T; const int t0 = qt * 32;
    const bf16_t* qp = Q + (tb + t0 + tq) * 1024 + hd * 128 + 8 * h;
    bf16x8 qf[8];
#pragma unroll
    for (int c = 0; c < 8; ++c) qf[c] = *(const bf16x8*)(qp + 16 * c);
    f32x16 o[4];
#pragma unroll
    for (int e = 0; e < 4; ++e) o[e] = zero16();
    float carry = 0.f;
    const int sg = (tq & 19) | ((tq & 4) << 1) | ((tq & 8) >> 1);
    const float scale = 0.08838834764831845f;
    for (int kt = qt; kt >= 0; --kt) {
        const int s0 = kt * 32;
        const bf16_t* kp = Kb + (tb + s0 + sg) * 1024 + hd * 128 + 8 * h;
        bf16x8 kf[8];
#pragma unroll
        for (int c = 0; c < 8; ++c) kf[c] = *(const bf16x8*)(kp + 16 * c);
        bf16x8 vf[4][2];
#pragma unroll
        for (int e = 0; e < 4; ++e)
#pragma unroll
            for (int c2 = 0; c2 < 2; ++c2) vf[e][c2] = *(const bf16x8*)(VT + (size_t)(hd * 128 + 32 * e + tq) * M + tb + s0 + 16 * c2 + 8 * h);
        f32x16 z = zero16();
#pragma unroll
        for (int c = 0; c < 8; ++c) z = MFMA32(kf[c], qf[c], z);
        const bool diag = (kt == qt);
        float L[16], ls[16];
#pragma unroll
        for (int i = 0; i < 16; ++i) { const int kl = 16 * (i >> 3) + 8 * h + (i & 7);
            const float zz = z[i] * scale; const float sp = fmaxf(zz, 0.f) + __logf(1.f + __expf(-fabsf(zz)));
            const bool valid = !diag || (kl < tq);
            L[i] = valid ? -sp : 0.f; ls[i] = valid ? (zz - sp) : -1e30f; }
        float a = 0.f, bs = 0.f;
#pragma unroll
        for (int i = 0; i < 8; ++i) { a += L[i]; bs += L[8 + i]; }
        const float a2 = __shfl_xor(a, 32), b2 = __shfl_xor(bs, 32);
        float pz[16];
        float run = carry + bs + b2 + (h == 0 ? a2 : 0.f);
#pragma unroll
        for (int i = 7; i >= 0; --i) { pz[i] = __expf(ls[i] + run); run += L[i]; }
        run = carry + (h == 0 ? b2 : 0.f);
#pragma unroll
        for (int i = 15; i >= 8; --i) { pz[i] = __expf(ls[i] + run); run += L[i]; }
        carry += (a + a2) + (bs + b2);
        bf16x8 pf[2];
#pragma unroll
        for (int c2 = 0; c2 < 2; ++c2) { u32x4 w; w.x = pk2(pz[8 * c2], pz[8 * c2 + 1]); w.y = pk2(pz[8 * c2 + 2], pz[8 * c2 + 3]); w.z = pk2(pz[8 * c2 + 4], pz[8 * c2 + 5]); w.w = pk2(pz[8 * c2 + 6], pz[8 * c2 + 7]);
            pf[c2] = __builtin_bit_cast(bf16x8, w); }
#pragma unroll
        for (int e = 0; e < 4; ++e)
#pragma unroll
            for (int c2 = 0; c2 < 2; ++c2) o[e] = MFMA32(vf[e][c2], pf[c2], o[e]);
        if (__all(carry < -104.f)) break;
    }
    bf16_t* yp = Y + (tb + t0 + tq) * 1024 + hd * 128 + 4 * h;
#pragma unroll
    for (int e = 0; e < 4; ++e)
#pragma unroll
        for (int g = 0; g < 4; ++g) { u32x2 w; w.x = pk2(o[e][4 * g], o[e][4 * g + 1]); w.y = pk2(o[e][4 * g + 2], o[e][4 * g + 3]); *(u32x2*)(yp + 32 * e + 8 * g) = w; }
}

__device__ __forceinline__ void hg1_item(unsigned char* ws, int item, int lane) {
    const float* LOGFT = (const float*)(ws + R1_LOGFT); const bf16_t* KKT = (const bf16_t*)(ws + R1_KKT); const bf16_t* QQT = (const bf16_t*)(ws + R1_QQT); const bf16_t* VHT = (const bf16_t*)(ws + R1_VHT);
    bf16_t* QG = (bf16_t*)(ws + R2_QG); bf16_t* KG = (bf16_t*)(ws + R2_KG); float* DEC = (float*)(ws + WS_DEC); bf16_t* ST = (bf16_t*)(ws + R3_ST);
    const int db = item & 3, ch = item >> 2;
    const int n = ch & 127, hd = (ch >> 7) & 7, b = ch >> 10;
    const int d = lane & 31, h = lane >> 5;
    const int f = hd * 128 + db * 32 + d;
    const size_t tk = (size_t)b * T + n * 32;
    float G[32];
    { const float* lp = LOGFT + (size_t)f * M + tk;
#pragma unroll
      for (int i = 0; i < 8; ++i) { const f32x4 v = *(const f32x4*)(lp + 4 * i); G[4 * i] = v[0]; G[4 * i + 1] = v[1]; G[4 * i + 2] = v[2]; G[4 * i + 3] = v[3]; } }
    u32x4 kw[4], qw[4];
#pragma unroll
    for (int i = 0; i < 4; ++i) { kw[i] = *(const u32x4*)(KKT + (size_t)f * M + tk + 8 * i); qw[i] = *(const u32x4*)(QQT + (size_t)f * M + tk + 8 * i); }
    bf16x8 vf[4][2];
#pragma unroll
    for (int e = 0; e < 4; ++e)
#pragma unroll
        for (int c = 0; c < 2; ++c) vf[e][c] = *(const bf16x8*)(VHT + (size_t)(hd * 128 + 32 * e + d) * M + tk + 16 * c + 8 * h);
#pragma unroll
    for (int t = 1; t < 32; ++t) G[t] += G[t - 1];
    const float Gl = G[31];
    float kd[32];
#pragma unroll
    for (int t = 0; t < 32; ++t) {
        const unsigned kwv = kw[t >> 3][(t >> 1) & 3], qwv = qw[t >> 3][(t >> 1) & 3];
        const float kk = (t & 1) ? bfhi(kwv) : bflo(kwv), qq = (t & 1) ? bfhi(qwv) : bflo(qwv);
        const float qg = qq * __expf(G[t]), kg = kk * __expf(-G[t]);
        kd[t] = kk * __expf(Gl - G[t]);
        if (((t >> 3) & 1) == h) { const size_t o = (tk + t) * 1024 + f; QG[o] = (bf16_t)(pk2(qg, 0.f) & 0xffffu); KG[o] = (bf16_t)(pk2(kg, 0.f) & 0xffffu); }
    }
    if (h == 0) DEC[(size_t)ch * 128 + db * 32 + d] = __expf(Gl);
    bf16x8 af[2];
#pragma unroll
    for (int c = 0; c < 2; ++c) { float s[8];
#pragma unroll
        for (int j = 0; j < 8; ++j) s[j] = h ? kd[16 * c + 8 + j] : kd[16 * c + j];
        u32x4 w; w.x = pk2(s[0], s[1]); w.y = pk2(s[2], s[3]); w.z = pk2(s[4], s[5]); w.w = pk2(s[6], s[7]); af[c] = __builtin_bit_cast(bf16x8, w); }
#pragma unroll
    for (int e = 0; e < 4; ++e) { f32x16 acc = zero16();
#pragma unroll
        for (int c = 0; c < 2; ++c) acc = MFMA32(af[c], vf[e][c], acc);
        bf16_t* sp = ST + ((size_t)ch * 128 + 32 * e + d) * 128 + db * 32 + 4 * h;
#pragma unroll
        for (int g = 0; g < 4; ++g) { u32x2 w; w.x = pk2(acc[4 * g], acc[4 * g + 1]); w.y = pk2(acc[4 * g + 2], acc[4 * g + 3]); *(u32x2*)(sp + 8 * g) = w; } }
}

__device__ void hg2_scan(unsigned char* ws) {
    bf16_t* ST = (bf16_t*)(ws + R3_ST); const float* DEC = (const float*)(ws + WS_DEC);
    const int gt = blockIdx.x * NTHR + ltid(), nt = gridDim.x * NTHR;
    for (int i = gt; i < 32 * 128 * 32; i += nt) {
        const int dq = i & 31, e = (i >> 5) & 127, bh = i >> 12;
        float s0 = 0.f, s1 = 0.f, s2 = 0.f, s3 = 0.f;
        bf16_t* sp = ST + ((size_t)bh * 128 * 128 + e) * 128 + 4 * dq;
        const float* dp = DEC + (size_t)bh * 128 * 128 + 4 * dq;
#pragma unroll 4
        for (int n = 0; n < 128; ++n) {
            const u32x2 w = *(const u32x2*)(sp + (size_t)n * 16384); const f32x4 dc = *(const f32x4*)(dp + n * 128);
            u32x2 o; o.x = pk2(s0, s1); o.y = pk2(s2, s3); *(u32x2*)(sp + (size_t)n * 16384) = o;
            s0 = dc[0] * s0 + bflo(w.x); s1 = dc[1] * s1 + bfhi(w.x); s2 = dc[2] * s2 + bflo(w.y); s3 = dc[3] * s3 + bfhi(w.y);
        }
    }
}

__device__ __forceinline__ void hg3_item(unsigned char* ws, const float* ghg, int ch, int lane) {
    const bf16_t* QG = (const bf16_t*)(ws + R2_QG); const bf16_t* KG = (const bf16_t*)(ws + R2_KG); const bf16_t* VHT = (const bf16_t*)(ws + R1_VHT);
    const bf16_t* ST = (const bf16_t*)(ws + R3_ST); const bf16_t* SHG = (const bf16_t*)(ws + R4_SHG); bf16_t* Y = (bf16_t*)(ws + HB_YHG);
    const int n = ch & 127, hd = (ch >> 7) & 7, b = ch >> 10;
    const int tq = lane & 31, h = lane >> 5;
    const size_t tk = (size_t)b * T + n * 32;
    const int sg = (tq & 19) | ((tq & 4) << 1) | ((tq & 8) >> 1);
    const bf16_t* qp = QG + (tk + tq) * 1024 + hd * 128 + 8 * h;
    const bf16_t* kp = KG + (tk + sg) * 1024 + hd * 128 + 8 * h;
    bf16x8 qf[8];
#pragma unroll
    for (int c = 0; c < 8; ++c) qf[c] = *(const bf16x8*)(qp + 16 * c);
    f32x16 z = zero16();
#pragma unroll
    for (int c = 0; c < 8; ++c) z = MFMA32(*(const bf16x8*)(kp + 16 * c), qf[c], z);
    bf16x8 pf[2];
#pragma unroll
    for (int c2 = 0; c2 < 2; ++c2) { float s[8];
#pragma unroll
        for (int j = 0; j < 8; ++j) { const int kl = 16 * c2 + 8 * h + j; s[j] = (kl <= tq) ? z[8 * c2 + j] : 0.f; }
        u32x4 w; w.x = pk2(s[0], s[1]); w.y = pk2(s[2], s[3]); w.z = pk2(s[4], s[5]); w.w = pk2(s[6], s[7]); pf[c2] = __builtin_bit_cast(bf16x8, w); }
    f32x16 o[4];
#pragma unroll
    for (int e = 0; e < 4; ++e) { o[e] = zero16();
#pragma unroll
        for (int c2 = 0; c2 < 2; ++c2) o[e] = MFMA32(*(const bf16x8*)(VHT + (size_t)(hd * 128 + 32 * e + tq) * M + tk + 16 * c2 + 8 * h), pf[c2], o[e]);
        const bf16_t* sp = ST + ((size_t)ch * 128 + 32 * e + tq) * 128 + 8 * h;
#pragma unroll
        for (int c = 0; c < 8; ++c) o[e] = MFMA32(*(const bf16x8*)(sp + 16 * c), qf[c], o[e]); }
    float ss = 0.f;
#pragma unroll
    for (int e = 0; e < 4; ++e)
#pragma unroll
        for (int i = 0; i < 16; ++i) ss += o[e][i] * o[e][i];
    ss += __shfl_xor(ss, 32);
    const float rs = rsqrtf(ss * (1.f / 128.f) + EPS);
    const size_t ob = (tk + tq) * 1024 + hd * 128 + 4 * h;
#pragma unroll
    for (int e = 0; e < 4; ++e)
#pragma unroll
        for (int g = 0; g < 4; ++g) { const int e0 = 32 * e + 8 * g;
            const f32x4 gn = *(const f32x4*)(ghg + hd * 128 + 4 * h + e0); const u32x2 gw = *(const u32x2*)(SHG + ob + e0);
            u32x2 w; w.x = pk2(o[e][4 * g] * rs * gn[0] * bflo(gw.x), o[e][4 * g + 1] * rs * gn[1] * bfhi(gw.x));
            w.y = pk2(o[e][4 * g + 2] * rs * gn[2] * bflo(gw.y), o[e][4 * g + 3] * rs * gn[3] * bfhi(gw.y));
            *(u32x2*)(Y + ob + e0) = w; }
}

__global__ void __launch_bounds__(NTHR, 2) fwd_kernel(Params p) {
    extern __shared__ __attribute__((aligned(16))) unsigned char lds_raw[];
    LAS unsigned char* lds = (LAS unsigned char*)lds_raw;
    float* ldsf = (float*)lds_raw;
    cg::grid_group grid = cg::this_grid();
    unsigned char* ws = p.ws;
    const int nw = gridDim.x * 8;
    bf16_t* Wb = (bf16_t*)(ws + WS_W); bf16_t* HB = (bf16_t*)(ws + WS_HB);
    const float* cond = (const float*)(ws + WS_COND);

    prep_weights(p, 0, ldsf);
    ada_partials(p, ldsf);
    grid.sync();
    cond_finalize(p);
    grid.sync();
    rowpass<0>(p.x, nullptr, nullptr, HB, nullptr, nullptr, p.g_pre_mix, cond + 2048, cond);
    grid.sync();
#pragma clang loop unroll(disable)
    for (int l = 0; l < 2; ++l) {
        const float* condl = cond + (size_t)l * 4 * NADA;
        run_gemm<1>(lds, HB, Wb + W_IN, M, NG1, D, ws, nullptr);
        run_gemm<2>(lds, Wb + W_IN + (size_t)NG1 * D, HB, NG2, M, D, ws, (const float*)(ws + WS_LB) + l * 1024);
        grid.sync();
        { const int tid = ltid(), lane = tid & 63, gw = blockIdx.x * 8 + (tid >> 6);
        for (int it = gw; it < 4096 + 16384; it += nw) {
            if (it < 4096) attn_item((const bf16_t*)(ws + R1_Q), (const bf16_t*)(ws + R1_K), (const bf16_t*)(ws + R1_VT), (bf16_t*)(ws + HB_YSB), it, lane);
            else hg1_item(ws, it - 4096, lane);
        } }
        grid.sync();
        hg2_scan(ws);
        grid.sync();
        { const int tid = ltid(), lane = tid & 63, gw = blockIdx.x * 8 + (tid >> 6);
        for (int it = gw; it < 4096; it += nw) hg3_item(ws, p.g_hg + l * 1024, it, lane); }
        grid.sync();
        run_gemm<3>(lds, (const bf16_t*)(ws + HB_YSB), Wb + W_SB, M, D, 1024, ws, nullptr);
        run_gemm<4>(lds, (const bf16_t*)(ws + HB_YHG), Wb + W_HG, M, D, 1024, ws, nullptr);
        grid.sync();
        run_gemm<5>(lds, (const bf16_t*)(ws + R2_MERGED), Wb + W_OUT, M, D, D, ws, nullptr);
        grid.sync();
        rowpass<1>(l == 0 ? p.x : p.out, (const float*)(ws + R3_MIX), p.out, HB, p.g_post_mix + l * D, condl + 2 * D, p.g_pre_mlp + l * D, condl + 4 * D, condl + 3 * D);
        grid.sync();
        run_gemm<6>(lds, HB, Wb + W_UP, M, FF, D, ws, nullptr);
        grid.sync();
        run_gemm<5>(lds, (const bf16_t*)(ws + R1_U), Wb + W_DN, M, D, FF, ws, nullptr);
        grid.sync();
        if (l == 0) {
            const float* cond1 = cond + (size_t)4 * NADA;
            rowpass<1>(p.out, (const float*)(ws + R3_MIX), p.out, HB, p.g_post_mlp, condl + 5 * D, p.g_pre_mix + D, cond1 + D, cond1);
            prep_weights(p, 1, ldsf);
            grid.sync();
        } else {
            rowpass<2>(p.out, (const float*)(ws + R3_MIX), p.out, nullptr, p.g_post_mlp + D, condl + 5 * D, nullptr, nullptr, nullptr);
        }
    }
}

extern "C" void kernel_launch(void* const* d_in, const int* in_sizes, int n_in, void* d_out, int out_size, void* d_ws, size_t ws_size, hipStream_t stream) {
    static int grid = 0;
    if (grid == 0) {
        if (n_in != 16 || out_size != M * D || ws_size < WS_END) { fprintf(stderr, "kernel_launch: unexpected shapes: n_in %d out %d ws %zu (need %zu)\n", n_in, out_size, ws_size, (size_t)WS_END); grid = -1; return; }
        int dev = 0, cus = 0, per_cu = 0;
        hipGetDevice(&dev); hipDeviceGetAttribute(&cus, hipDeviceAttributeMultiprocessorCount, dev);
        if (hipFuncSetAttribute((const void*)fwd_kernel, hipFuncAttributeMaxDynamicSharedMemorySize, LDS_BYTES) != hipSuccess) { fprintf(stderr, "kernel_launch: hipFuncSetAttribute failed\n"); grid = -1; return; }
        hipOccupancyMaxActiveBlocksPerMultiprocessor(&per_cu, (const void*)fwd_kernel, NTHR, LDS_BYTES);
        (void)hipGetLastError();
        if (per_cu < 1) { fprintf(stderr, "kernel_launch: occupancy query says %d blocks per CU\n", per_cu); per_cu = 1; }
        grid = cus;
    }
    if (grid < 0) return;
    Params p{};
    p.x = (const float*)d_in[0]; p.c = (const float*)d_in[1]; p.w_ada = (const float*)d_in[2]; p.b_ada = (const float*)d_in[3]; p.g_pre_mix = (const float*)d_in[4]; p.g_post_mix = (const float*)d_in[5];
    p.w_in = (const float*)d_in[6]; p.lb_logits = (const float*)d_in[7]; p.g_hg = (const float*)d_in[8]; p.w_sb = (const float*)d_in[9]; p.w_hg = (const float*)d_in[10]; p.w_out = (const float*)d_in[11];
    p.g_pre_mlp = (const float*)d_in[12]; p.g_post_mlp = (const float*)d_in[13]; p.w_up = (const float*)d_in[14]; p.w_dn = (const float*)d_in[15];
    p.out = (float*)d_out; p.ws = (unsigned char*)d_ws;
    void* args[] = {&p};
    hipError_t e = hipLaunchCooperativeKernel((const void*)fwd_kernel, dim3(grid), dim3(NTHR), args, LDS_BYTES, stream);
    if (e != hipSuccess) fprintf(stderr, "kernel_launch: cooperative launch failed: %s (grid %d)\n", hipGetErrorString(e), grid);
}
```

```cpp
#include <hip/hip_runtime.h>
#include <hip/hip_cooperative_groups.h>
#include <cstdio>
namespace cg = cooperative_groups;

namespace pg8 {
#define PG8_LAS __attribute__((address_space(3)))
typedef unsigned short bf16_t;
typedef short bf16x8 __attribute__((ext_vector_type(8)));
typedef float f32x4 __attribute__((ext_vector_type(4)));
typedef unsigned u32x4 __attribute__((ext_vector_type(4)));
constexpr int BM = 256, BK = 64, HALF = 128, HTB = HALF * BK * 2  , STAGE_BYTES = 8 * HTB, NXCD = 8, WGM = 4;

__host__ __device__ __forceinline__ int lds_byte(int r, int c) { const int st = (r >> 4) * 2 + (c >> 5), rr = r & 15, cc = c & 31, ob = rr * 64 + cc * 2; return st * 1024 + (ob ^ (((ob >> 9) & 1) << 5)); }
__host__ __device__ __forceinline__ void stage_rc(int b, int& R, int& C) { const int st = b / 1024, sb = b % 1024, swz = sb ^ (((sb >> 9) & 1) << 5); R = (st >> 1) * 16 + swz / 64; C = (st & 1) * 32 + (swz % 64) / 2; }
__host__ __device__ __forceinline__ int perm32(int rho) { const int n = rho >> 4, i = rho & 15; return 8 * (i >> 2) + 4 * n + (i & 3); }

struct Unit { int pm, pn; };
struct Gemm { const bf16_t* A; const bf16_t* Bt; int M, N, K; };

struct StaticOrder {
    int nM, nN, nwg, G, c, wgm;
    __host__ __device__ void init(int M, int N, int G_, int c_) { nM = M / BM; nN = N / BM; nwg = nM * nN; G = G_; c = c_; wgm = WGM; }
    __host__ __device__ bool next(int i, Unit& u) const {
        const long L = (long)i * G + c; if (L >= nwg) return false;
        int wgid = (int)L; { const int q = nwg / NXCD, r = nwg % NXCD, xcd = wgid % NXCD, off = wgid / NXCD; wgid = (xcd < r ? xcd * (q + 1) : r * (q + 1) + (xcd - r) * q) + off; }
        const int nig = wgm * nN, gid = wgid / nig, fm = gid * wgm, gsz = (nM - fm) < wgm ? (nM - fm) : wgm;
        u.pm = fm + ((wgid % nig) % gsz); u.pn = (wgid % nig) / gsz; return true;
    }
    __device__ __forceinline__ void a_ready(const Unit&) const {}
    __device__ __forceinline__ void done(const Unit&) const {}
};
__device__ __forceinline__ unsigned cvt_pk_bf16(float lo, float hi) { unsigned r; asm volatile("v_cvt_pk_bf16_f32 %0, %1, %2" : "=v"(r) : "v"(lo), "v"(hi)); return r; }
template <class Epi, class Sched, bool STAMP = false>
__device__ __forceinline__ void gemm_phase(PG8_LAS unsigned char* lds, const Gemm g, const Sched& S, const Epi& E, unsigned long long* stamps) {
    unsigned ones_l = ~0u; asm volatile("" : "+s"(ones_l)); const int tid_l = (S.wv << 6) | (int)__builtin_amdgcn_mbcnt_hi(ones_l, __builtin_amdgcn_mbcnt_lo(ones_l, 0u));
    const int tid = tid_l, wid = __builtin_amdgcn_readfirstlane(tid >> 6), lane = tid & 63, wr = wid >> 2, wc = wid & 3, fr = lane & 15, fq = lane >> 4;
    const int K = g.K, nt = K / BK;
    int ts_lo = 0, ts_hi = 0, nts = 0; const unsigned long long rt_entry = STAMP ? (unsigned long long)wall_clock64() : 0ull;
#define PG8_STAMP() do { if (STAMP && wid == 0 && nts < 64) { const unsigned long long _c = (unsigned long long)clock64(); \
        ts_lo = (lane == nts) ? (int)(unsigned)_c : ts_lo; ts_hi = (lane == nts) ? (int)(unsigned)(_c >> 32) : ts_hi; ++nts; } } while (0)
    PG8_STAMP();
    unsigned voffA[2], voffB[2];
#pragma unroll
    for (int i = 0; i < 2; ++i) { int R, C; stage_rc(tid * 16 + i * 8192, R, C); const int Rb = Epi::PERM ? ((R & ~31) + perm32(R & 31)) : R;
        voffA[i] = (unsigned)(R * K + C) * 2u; voffB[i] = (unsigned)(Rb * K + C) * 2u; }
    const size_t kstep = (size_t)(BK * 2);
    const size_t hstep = (size_t)HALF * K * 2;
    const size_t tstep = 2 * hstep;
    const unsigned ldsw = (unsigned)wid * 1024u;
    const int aoff = lds_byte(wr * 64 + fr, fq * 8), boff = lds_byte(wc * 32 + fr, fq * 8);
#define PG8_SA(b, h) (((b) * 2 + (h)) * HTB)
#define PG8_SB(b, h) ((4 + (b) * 2 + (h)) * HTB)
#define PG8_STAGE(bufoff, gbase, voff) do { _Pragma("unroll") for (int _i = 0; _i < 2; ++_i) \
        __builtin_amdgcn_global_load_lds((const unsigned*)((const char*)(gbase) + (voff)[_i]), (PG8_LAS unsigned*)(lds + (bufoff) + ldsw + _i * 8192), 16, 0, 0); } while (0)
#define PG8_LDA(dst, b, h) do { _Pragma("unroll") for (int m = 0; m < 4; ++m) _Pragma("unroll") for (int k = 0; k < 2; ++k) dst[m][k] = *(const PG8_LAS bf16x8*)(lds + PG8_SA(b, h) + aoff + m * 2048 + k * 1024); } while (0)
#define PG8_LDB(dst, b, h) do { _Pragma("unroll") for (int n = 0; n < 2; ++n) _Pragma("unroll") for (int k = 0; k < 2; ++k) dst[n][k] = *(const PG8_LAS bf16x8*)(lds + PG8_SB(b, h) + boff + n * 2048 + k * 1024); } while (0)
#define PG8_MMA(ai, bj, At, Bt) do { __builtin_amdgcn_s_setprio(1); _Pragma("unroll") for (int m = 0; m < 4; ++m) _Pragma("unroll") for (int n = 0; n < 2; ++n) _Pragma("unroll") for (int k = 0; k < 2; ++k) \
        acc[ai][bj][m][n] = __builtin_amdgcn_mfma_f32_16x16x32_bf16(Bt[n][k], At[m][k], acc[ai][bj][m][n], 0, 0, 0); __builtin_amdgcn_s_setprio(0); } while (0)
#define PG8_WAIT_V(n) asm volatile("s_waitcnt vmcnt(" #n ")" ::: "memory")
#define PG8_WAIT_L(n) asm volatile("s_waitcnt lgkmcnt(" #n ")" ::: "memory")
#define PG8_BAR __builtin_amdgcn_s_barrier()
#define PG8_SCHED __builtin_amdgcn_sched_barrier(0)
    Unit cur, nxt; int ui = 0;
    if (!S.next(0, cur)) return;
    f32x4 acc[2][2][4][2];
#pragma unroll
    for (int a = 0; a < 2; ++a)
#pragma unroll
        for (int b = 0; b < 2; ++b)
#pragma unroll
            for (int m = 0; m < 4; ++m)
#pragma unroll
                for (int n = 0; n < 2; ++n) acc[a][b][m][n] = (f32x4){0.f, 0.f, 0.f, 0.f};
    bf16x8 At[4][2], B0[2][2], B1[2][2];
    const char* cA = (const char*)g.A + (size_t)cur.pm * tstep; const char* cB = (const char*)g.Bt + (size_t)cur.pn * tstep;
    S.a_ready(cur);
    PG8_STAGE(PG8_SB(0, 0), cB, voffB); PG8_STAGE(PG8_SA(0, 0), cA, voffA); PG8_STAGE(PG8_SB(0, 1), cB + hstep, voffB); PG8_STAGE(PG8_SA(0, 1), cA + hstep, voffA);
    if (wr == 1) PG8_BAR;
    PG8_WAIT_V(4); PG8_BAR;
    PG8_STAGE(PG8_SB(1, 0), cB + kstep, voffB); PG8_STAGE(PG8_SA(1, 0), cA + kstep, voffA); PG8_STAGE(PG8_SB(1, 1), cB + hstep + kstep, voffB);
    PG8_WAIT_V(6); PG8_BAR;
    PG8_STAMP();
    for (;;) {
        const bool has_next = S.next(ui + 1, nxt);
        const char* nA = has_next ? (const char*)g.A + (size_t)nxt.pm * tstep : cA; const char* nB = has_next ? (const char*)g.Bt + (size_t)nxt.pn * tstep : cB;
        for (int t = 0; t < nt; t += 2) {
            const bool last = (t == nt - 2);
            const char* a1 = cA + (size_t)(t + 1) * kstep;
            const char* a2 = last ? nA : cA + (size_t)(t + 2) * kstep; const char* b2 = last ? nB : cB + (size_t)(t + 2) * kstep;
            const char* a3 = a2 + kstep; const char* b3 = b2 + kstep;
            if (last && has_next) S.a_ready(nxt);
            if constexpr (Epi::MID) { if (t == (nt >> 1)) E.mid(acc, cur, wr, wc, fr, fq); }
            PG8_LDB(B0, 0, 0); PG8_SCHED; PG8_LDA(At, 0, 0); PG8_STAGE(PG8_SA(1, 1), a1 + hstep, voffA);
            PG8_WAIT_L(8); PG8_BAR; PG8_WAIT_L(0); PG8_MMA(0, 0, At, B0); PG8_BAR; PG8_SCHED;
            PG8_LDB(B1, 0, 1); PG8_STAGE(PG8_SB(0, 0), b2, voffB);
            PG8_BAR; PG8_WAIT_L(0); PG8_MMA(0, 1, At, B1); PG8_BAR;
            PG8_LDA(At, 0, 1); PG8_STAGE(PG8_SA(0, 0), a2, voffA);
            PG8_BAR; PG8_WAIT_L(0); PG8_MMA(1, 0, At, B0); PG8_BAR; PG8_SCHED;
            PG8_STAGE(PG8_SB(0, 1), b2 + hstep, voffB);
            PG8_WAIT_V(6); PG8_BAR; PG8_MMA(1, 1, At, B1); PG8_BAR;
            PG8_LDB(B0, 1, 0); PG8_SCHED; PG8_LDA(At, 1, 0); PG8_STAGE(PG8_SA(0, 1), a2 + hstep, voffA);
            PG8_WAIT_L(8); PG8_BAR; PG8_WAIT_L(0); PG8_MMA(0, 0, At, B0); PG8_BAR; PG8_SCHED;
            PG8_LDB(B1, 1, 1); PG8_STAGE(PG8_SB(1, 0), b3, voffB);
            PG8_BAR; PG8_WAIT_L(0); PG8_MMA(0, 1, At, B1); PG8_BAR;
            PG8_LDA(At, 1, 1); PG8_STAGE(PG8_SA(1, 0), a3, voffA);
            PG8_BAR; PG8_WAIT_L(0); PG8_MMA(1, 0, At, B0); PG8_BAR; PG8_SCHED;
            PG8_STAGE(PG8_SB(1, 1), b3 + hstep, voffB);
            PG8_WAIT_V(6); PG8_BAR; PG8_MMA(1, 1, At, B1); PG8_BAR;
        }
        PG8_STAMP();
        if constexpr (!Epi::AFTER_DRAIN) { E(acc, cur, wr, wc, fr, fq); S.done(cur); }
        PG8_STAMP();
        if (!has_next) break;
#pragma unroll
        for (int a = 0; a < 2; ++a)
#pragma unroll
            for (int b = 0; b < 2; ++b)
#pragma unroll
                for (int m = 0; m < 4; ++m)
#pragma unroll
                    for (int n = 0; n < 2; ++n) acc[a][b][m][n] = (f32x4){0.f, 0.f, 0.f, 0.f};
        cur = nxt; cA = nA; cB = nB; ++ui;
    }
    PG8_WAIT_V(0);
    if (wr == 0) PG8_BAR;
    PG8_BAR;
    if constexpr (Epi::AFTER_DRAIN) { E.fused(acc, cur, wr, wc, fr, fq, lds, wid, lane); S.done(cur); }
    PG8_STAMP();
    if (STAMP && wid == 0) { stamps[lane] = lane < nts ? (((unsigned long long)(unsigned)ts_hi << 32) | (unsigned)ts_lo) : 0ull;
        if (lane == 62) stamps[62] = rt_entry; if (lane == 63) stamps[63] = (unsigned long long)wall_clock64(); }
#undef PG8_STAMP
#undef PG8_SA
#undef PG8_SB
#undef PG8_STAGE
#undef PG8_LDA
#undef PG8_LDB
#undef PG8_MMA
#undef PG8_WAIT_V
#undef PG8_WAIT_L
#undef PG8_BAR
#undef PG8_SCHED
}
}

using pg8::bf16_t; using pg8::bf16x8; using pg8::f32x4; using pg8::u32x4;
typedef float f32x16 __attribute__((ext_vector_type(16)));
typedef float f32x2 __attribute__((ext_vector_type(2)));
typedef unsigned u32x2 __attribute__((ext_vector_type(2)));
typedef __bf16 bf2_t __attribute__((ext_vector_type(2)));
#define LAS PG8_LAS
#define MFMA32(a, b, c) __builtin_amdgcn_mfma_f32_32x32x16_bf16((a), (b), (c), 0, 0, 0)

constexpr int D = 2048, NB = 4, T = 4096, M = NB * T, FF = 8192, NADA = 6 * D;
constexpr int NG1 = 7168, NG2 = 4096;
constexpr float EPS = 1e-6f;
constexpr int NTHR = 512, LDS_BYTES = 131072;
#ifndef G2WGM
#define G2WGM 16
#endif
#ifndef GSTAG
#define GSTAG 0
#endif
constexpr size_t MiB = (size_t)1 << 20;
constexpr size_t W_IN = 0, W_SB = 23068672, W_HG = W_SB + 2097152, W_OUT = W_HG + 2097152, W_UP = W_OUT + 4194304, W_DN = W_UP + 16777216;
constexpr size_t WS_W = 0, WS_HB = 124 * MiB, WS_R1 = 188 * MiB, WS_R2 = 444 * MiB, WS_R3 = 508 * MiB, WS_R4 = 636 * MiB, WS_R5 = 668 * MiB, WS_SM = 796 * MiB;
constexpr size_t WS_PART = WS_SM, WS_COND = WS_SM + 6 * MiB, WS_LB = WS_COND + 393216, WS_BAR = WS_COND + 512 * 1024, WS_DEC = WS_SM + 7 * MiB, WS_END = WS_SM + 9 * MiB;
constexpr size_t R1_Q = WS_R1, R1_K = WS_R1 + 32 * MiB, R1_VT = WS_R1 + 64 * MiB, R1_QQT = WS_R1 + 96 * MiB, R1_KKT = WS_R1 + 128 * MiB, R1_VHT = WS_R1 + 160 * MiB, R1_LOGFT = WS_R1 + 192 * MiB;
constexpr size_t R1_PBUF = WS_R1, R1_U = WS_R1;
constexpr size_t R2_QG = WS_R2, R2_KG = WS_R2 + 32 * MiB, R2_MERGED = WS_R2;
constexpr size_t R3_ST = WS_R3, R3_MIX = WS_R3, R3_MLP = WS_R3 + 64 * MiB;
constexpr size_t R4_SHG = WS_R4, R5_SGA = WS_R5, R5_SGB = WS_R5 + 64 * MiB;
constexpr size_t HB_YSB = WS_HB, HB_YHG = WS_HB + 2048;

struct WvOrder : pg8::StaticOrder { int wv; };
struct Params {
    const float* x; const float* c; const float* w_ada; const float* b_ada; const float* g_pre_mix; const float* g_post_mix; const float* w_in; const float* lb_logits;
    const float* g_hg; const float* w_sb; const float* w_hg; const float* w_out; const float* g_pre_mlp; const float* g_post_mlp; const float* w_up; const float* w_dn;
    float* out; unsigned char* ws;
};

__device__ __forceinline__ unsigned pk2(float a, float b) { f32x2 v = {a, b}; bf2_t r = __builtin_convertvector(v, bf2_t); return __builtin_bit_cast(unsigned, r); }
__device__ __forceinline__ float bflo(unsigned w) { return __uint_as_float(w << 16); }
__device__ __forceinline__ float bfhi(unsigned w) { return __uint_as_float(w & 0xffff0000u); }
__device__ __forceinline__ float sigm(float x) { return __builtin_amdgcn_rcpf(1.f + __builtin_amdgcn_exp2f(x * -1.4426950408889634f)); }
__device__ __forceinline__ float silu_(float x) { return x * __builtin_amdgcn_rcpf(1.f + __builtin_amdgcn_exp2f(x * -1.4426950408889634f)); }
__device__ __forceinline__ int ltid(int wv) { unsigned ones = ~0u; asm volatile("" : "+s"(ones));
    return (wv << 6) | (int)__builtin_amdgcn_mbcnt_hi(ones, __builtin_amdgcn_mbcnt_lo(ones, 0u)); }
#define XB_TMO      128
#define XB_XCNT(j)  (256  + 64 * (j))
#define XB_XSUB(j)  (1280 + 64 * (j))
#define XB_XGEN(j)  (2304 + 64 * (j))
#define XB_TOP      3328
#define XB_TOPGEN   3392
#define XCD_BAR_WORDS 3456
#define XB_SPIN_CAP (1u << 22)
__device__ __forceinline__ unsigned xb_ld(unsigned* p)              { return __hip_atomic_load(p, __ATOMIC_RELAXED, __HIP_MEMORY_SCOPE_AGENT); }
__device__ __forceinline__ unsigned xb_add(unsigned* p, unsigned v) { return __hip_atomic_fetch_add(p, v, __ATOMIC_RELAXED, __HIP_MEMORY_SCOPE_AGENT); }
__device__ __forceinline__ unsigned xb_xcc_id() { return (unsigned)__builtin_amdgcn_s_getreg((3 << 11) | 20) & 0xFu; }
#define XB_SPIN(cond, bar) do { unsigned _sp = 0; while (cond) { __builtin_amdgcn_s_sleep(1); \
    if ((++_sp & 255u) == 0u) { if (xb_ld(&(bar)[XB_TMO])) break; if (_sp > XB_SPIN_CAP) { atomicAdd(&(bar)[XB_TMO], 1u); break; } } } } while (0)
__device__ __forceinline__ void xcd_barrier_complete(unsigned* bar, unsigned x, unsigned& nloc, unsigned& nx) {
    const unsigned G = gridDim.x;
    unsigned sum, cnt, mine, sp = 0u;
    for (;;) {
        sum = 0u; cnt = 0u; mine = 0u;
#pragma unroll
        for (unsigned j = 0; j < 16; ++j) { const unsigned c = xb_ld(&bar[XB_XCNT(j)]); sum += c; cnt += (c > 0u) ? 1u : 0u; mine = (j == x) ? c : mine; }
        if (sum == G) break;
        __builtin_amdgcn_s_sleep(1);
        if ((++sp & 255u) == 0u) { if (xb_ld(&bar[XB_TMO])) break; if (sp > XB_SPIN_CAP) { atomicAdd(&bar[XB_TMO], 1u); break; } }
    }
    nloc = mine > 0u ? mine : 1u; nx = cnt > 0u ? cnt : 1u;
}
__device__ __forceinline__ void grid_bar(unsigned* bar_in, volatile LAS unsigned* st, int wv) {
    unsigned* bar = bar_in; asm volatile("" : "+s"(bar));
    asm volatile("s_waitcnt vmcnt(0)" ::: "memory");
    __syncthreads();
    if (ltid(wv) == 0) {
        const unsigned x = xb_xcc_id();
        __builtin_amdgcn_s_waitcnt(0);
        unsigned nloc = st[0], nx = st[1];
        if (nloc == 0u) { xcd_barrier_complete(bar, x, nloc, nx); st[0] = nloc; st[1] = nx; }
        const unsigned old = xb_add(&bar[XB_XSUB(x)], 1u);
        const unsigned gen = old / nloc;
        if (old + 1u == (gen + 1u) * nloc) {
            __builtin_amdgcn_fence(__ATOMIC_RELEASE, "agent");
            asm volatile("s_waitcnt vmcnt(0)" ::: "memory");
            const unsigned og = xb_add(&bar[XB_TOP], 1u);
            const unsigned tg = og / nx;
            if (og + 1u == (tg + 1u) * nx) xb_add(&bar[XB_TOPGEN], 1u);
            else XB_SPIN(xb_ld(&bar[XB_TOPGEN]) == tg, bar);
            __builtin_amdgcn_fence(__ATOMIC_ACQUIRE, "agent");
            xb_add(&bar[XB_XGEN(x)], 1u);
            asm volatile("s_waitcnt vmcnt(0)" ::: "memory");
        } else {
            XB_SPIN(xb_ld(&bar[XB_XGEN(x)]) == gen, bar);
            __builtin_amdgcn_fence(__ATOMIC_ACQUIRE, "agent");
            asm volatile("s_waitcnt vmcnt(0)" ::: "memory");
        }
    }
    __syncthreads();
}
__device__ __forceinline__ float shfl_xor_l(float v, int lane, int o) { return __int_as_float(__builtin_amdgcn_ds_bpermute((lane ^ o) << 2, __float_as_int(v))); }
__device__ __forceinline__ unsigned fm16_off(int f, int tok) { return (unsigned)(((tok >> 5) * 32 + (f >> 5)) * 1024 + ((((tok & 31) >> 3) * 32 + (f & 31)) * 8) + (tok & 7)); }
__device__ __forceinline__ unsigned fm32_off(int f, int tok) { return (unsigned)(((tok >> 5) * 32 + (f >> 5)) * 1024 + ((((tok & 31) >> 2) * 32 + (f & 31)) * 4) + (tok & 3)); }
__device__ __forceinline__ int swap23(int m) { return (m & 19) | ((m & 4) << 1) | ((m & 8) >> 1); }
__device__ __forceinline__ unsigned qk_off(int tok, int hd, int piece, int slot) { return (unsigned)(((((tok >> 5) * 8 + hd) * 16 + piece) * 32 + slot) * 8); }
__device__ __forceinline__ f32x16 zero16() { f32x16 z; _Pragma("unroll") for (int i = 0; i < 16; ++i) z[i] = 0.f; return z; }

template <int MODE> struct Epi {
    static constexpr bool PERM = true, AFTER_DRAIN = false, MID = (MODE == 4);
    unsigned char* ws; const float* lb;
    __device__ __forceinline__ void mid(f32x4 (&acc)[2][2][4][2], const pg8::Unit& u, int wr, int wc, int fr, int fq) const {
        unsigned rc = (unsigned)((u.pm * 256 + wr * 64 + fr) * D + u.pn * 256 + wc * 32 + 8 * fq);
        asm volatile("" : "+v"(rc));
        const bf16_t* SGA = (const bf16_t*)(ws + R5_SGA); const bf16_t* SGB = (const bf16_t*)(ws + R5_SGB);
#pragma unroll
        for (int ai = 0; ai < 2; ++ai)
#pragma unroll
            for (int m = 0; m < 4; ++m) {
#pragma unroll
                for (int bj = 0; bj < 2; ++bj) { const unsigned off = rc + (unsigned)((ai * 128 + m * 16) * D + bj * 128);
                    const u32x4 ga = *(const u32x4*)(SGA + off), gb = *(const u32x4*)(SGB + off);
                    const float ra[8] = {bflo(ga.x), bfhi(ga.x), bflo(ga.y), bfhi(ga.y), bflo(ga.z), bfhi(ga.z), bflo(ga.w), bfhi(ga.w)};
                    const float rb[8] = {bflo(gb.x), bfhi(gb.x), bflo(gb.y), bfhi(gb.y), bflo(gb.z), bfhi(gb.z), bflo(gb.w), bfhi(gb.w)};
#pragma unroll
                    for (int j = 0; j < 8; ++j) acc[ai][bj][m][j >> 2][j & 3] *= ra[j] * __builtin_amdgcn_rcpf(fmaxf(rb[j], 1e-30f));
                }
                asm volatile("" ::: "memory"); }
    }
    __device__ __forceinline__ void operator()(const f32x4 (&acc)[2][2][4][2], const pg8::Unit& u, int wr, int wc, int fr, int fq) const {
        const int row0 = u.pm * 256 + wr * 64 + fr, col0 = u.pn * 256 + wc * 32 + 8 * fq;
        bf16_t* base1 = nullptr; int ld1 = 1024, act1 = 0, cb1 = 0;
        if (MODE == 1) { const int ct = u.pn * 256;
            if (ct < 1024) { base1 = (bf16_t*)(ws + R1_Q); }
            else if (ct < 2048) { base1 = (bf16_t*)(ws + R1_K); cb1 = 1024; }
            else if (ct < 3072) { base1 = (bf16_t*)(ws + R4_SHG); cb1 = 2048; act1 = 1; }
            else if (ct < 5120) { base1 = (bf16_t*)(ws + R5_SGA); cb1 = 3072; act1 = 2; ld1 = 2048; }
            else { base1 = (bf16_t*)(ws + R5_SGB); cb1 = 5120; act1 = 2; ld1 = 2048; } }
        const int rt2 = u.pm * 256;
#pragma unroll
        for (int ai = 0; ai < 2; ++ai)
#pragma unroll
            for (int m = 0; m < 4; ++m) { const int row = row0 + ai * 128 + m * 16;
                float lbv = 0.f; if (MODE == 2) { if (rt2 >= 2048 && rt2 < 3072) lbv = lb[row - 2048]; }
#pragma unroll
                for (int bj = 0; bj < 2; ++bj) { const int col = col0 + bj * 128; const f32x4 v0 = acc[ai][bj][m][0], v1 = acc[ai][bj][m][1];
                    float v[8] = {v0[0], v0[1], v0[2], v0[3], v1[0], v1[1], v1[2], v1[3]};
                    if (MODE == 1) {
                        if (act1 == 1) { _Pragma("unroll") for (int j = 0; j < 8; ++j) v[j] = silu_(v[j]); }
                        else if (act1 == 2) { _Pragma("unroll") for (int j = 0; j < 8; ++j) v[j] = sigm(v[j]); }
                        u32x4 w; w.x = pk2(v[0], v[1]); w.y = pk2(v[2], v[3]); w.z = pk2(v[4], v[5]); w.w = pk2(v[6], v[7]);
                        if (cb1 < 2048) { const int cc = col - cb1; *(u32x4*)(base1 + qk_off(row, cc >> 7, (cc & 127) >> 3, cb1 ? swap23(row & 31) : (row & 31))) = w; }
                        else *(u32x4*)(base1 + (size_t)row * ld1 + (col - cb1)) = w;
                    } else if (MODE == 2) {
                        if (rt2 >= 2048 && rt2 < 3072) {
                            float lg[8];
                            _Pragma("unroll") for (int j = 0; j < 8; ++j) { const float xx = v[j]; const float ls = fminf(xx, 0.f) - __logf(1.f + __expf(-fabsf(xx)));
                                lg[j] = (lbv > 0.f) ? __logf(lbv + (1.f - lbv) * __expf(ls)) : ls; }
                            float* lp = (float*)(ws + R1_LOGFT) + fm32_off(row - 2048, col);
                            *(f32x4*)lp = (f32x4){lg[0], lg[1], lg[2], lg[3]}; *(f32x4*)(lp + 128) = (f32x4){lg[4], lg[5], lg[6], lg[7]};
                        } else {
                            bf16_t* b2; int rb;
                            if (rt2 < 1024) { b2 = (bf16_t*)(ws + R1_VT); rb = 0; } else if (rt2 < 2048) { b2 = (bf16_t*)(ws + R1_QQT); rb = 1024; _Pragma("unroll") for (int j = 0; j < 8; ++j) v[j] = silu_(v[j]); }
                            else { b2 = (bf16_t*)(ws + R1_VHT); rb = 3072; }
                            u32x4 w; w.x = pk2(v[0], v[1]); w.y = pk2(v[2], v[3]); w.z = pk2(v[4], v[5]); w.w = pk2(v[6], v[7]);
                            *(u32x4*)(b2 + fm16_off(row - rb, col)) = w;
                        }
                    } else if (MODE == 4) {
                        const u32x4 g = *(const u32x4*)((const bf16_t*)(ws + R5_SGB) + (size_t)row * D + col);
                        u32x4 w; w.x = pk2(v[0] * fmaxf(bflo(g.x), 1e-30f), v[1] * fmaxf(bfhi(g.x), 1e-30f)); w.y = pk2(v[2] * fmaxf(bflo(g.y), 1e-30f), v[3] * fmaxf(bfhi(g.y), 1e-30f));
                        w.z = pk2(v[4] * fmaxf(bflo(g.z), 1e-30f), v[5] * fmaxf(bfhi(g.z), 1e-30f)); w.w = pk2(v[6] * fmaxf(bflo(g.w), 1e-30f), v[7] * fmaxf(bfhi(g.w), 1e-30f));
                        *(u32x4*)((bf16_t*)(ws + R2_MERGED) + (size_t)row * D + col) = w;
                    } else if (MODE == 5) {
                        u32x4 w; w.x = pk2(v[0], v[1]); w.y = pk2(v[2], v[3]); w.z = pk2(v[4], v[5]); w.w = pk2(v[6], v[7]);
                        *(u32x4*)((bf16_t*)(ws + (lb ? R3_MLP : R3_MIX)) + (size_t)row * D + col) = w;
                    } else if (MODE == 6) {
                        _Pragma("unroll") for (int j = 0; j < 8; ++j) { const float r = fmaxf(v[j], 0.f); v[j] = r * r; }
                        u32x4 w; w.x = pk2(v[0], v[1]); w.y = pk2(v[2], v[3]); w.z = pk2(v[4], v[5]); w.w = pk2(v[6], v[7]);
                        *(u32x4*)((bf16_t*)(ws + R1_U) + (size_t)row * FF + col) = w;
                    }
                } }
    }
};

template <int MODE, int STAG = 0> __device__ __forceinline__ void run_gemm(LAS unsigned char* lds, const bf16_t* A, const bf16_t* Bt, int M_, int N_, int K_, unsigned char* ws, const float* lb, int wv) {
    if (STAG > 0) {
        const unsigned long long t0 = __builtin_amdgcn_s_memrealtime(); const unsigned long long dl = (unsigned long long)(((blockIdx.x >> 3) & 7) * STAG);
        while (__builtin_amdgcn_s_memrealtime() - t0 < dl) __builtin_amdgcn_s_sleep(4); }
    pg8::Gemm g{A, Bt, M_, N_, K_}; WvOrder S; S.init(M_, N_, (int)gridDim.x, (int)blockIdx.x); S.wv = wv; if (MODE == 2) S.wgm = G2WGM;
    Epi<MODE> E{ws, lb};
    pg8::gemm_phase<Epi<MODE>, WvOrder, false>(lds, g, S, E, nullptr);
}

struct PrepItem { const float* src; bf16_t* dst; int K, N, remap, ldk, koff, tn, tk; };
__device__ __forceinline__ PrepItem prep_item(const Params& p, bf16_t* Wb, int layer, int t4) {
    PrepItem q; int tt = t4 * 4; q.remap = 0; q.ldk = 0; q.koff = 0;
    if (tt < 5632) { q.src = p.w_in + (size_t)layer * 2048 * 11264; q.dst = Wb + W_IN; q.K = 2048; q.N = 11264; q.remap = 1; }
    else if ((tt -= 5632) < 512) { q.src = p.w_sb + (size_t)layer * 1024 * 2048; q.dst = Wb + W_SB; q.K = 1024; q.N = 2048; q.ldk = 2048; }
    else if ((tt -= 512) < 512) { q.src = p.w_hg + (size_t)layer * 1024 * 2048; q.dst = Wb + W_SB; q.K = 1024; q.N = 2048; q.ldk = 2048; q.koff = 1024; }
    else if ((tt -= 512) < 1024) { q.src = p.w_out + (size_t)layer * 2048 * 2048; q.dst = Wb + W_OUT; q.K = 2048; q.N = 2048; }
    else if ((tt -= 1024) < 4096) { q.src = p.w_up + (size_t)layer * 2048 * 8192; q.dst = Wb + W_UP; q.K = 2048; q.N = 8192; }
    else { tt -= 4096; q.src = p.w_dn + (size_t)layer * 8192 * 2048; q.dst = Wb + W_DN; q.K = 8192; q.N = 2048; }
    const int nk = q.K / 64; q.tn = tt / nk; q.tk = tt % nk;
    return q;
}
__device__ void prep_weights(const Params& p, int layer, float* tile, int wv) {
    const int tid = ltid(wv);
    bf16_t* Wb = (bf16_t*)(p.ws + WS_W);
    int t4 = blockIdx.x;
    if (t4 >= 3968) return;
    PrepItem q = prep_item(p, Wb, layer, t4);
    f32x4 v[8];
#pragma unroll
    for (int i = 0; i < 8; ++i) { const int idx = tid + i * 512, r = idx >> 4, c4 = (idx & 15) * 4; v[i] = *(const f32x4*)(q.src + (size_t)(q.tk * 64 + r) * q.N + q.tn * 64 + c4); }
    for (;;) {
#pragma unroll
        for (int i = 0; i < 8; ++i) { const int idx = tid + i * 512, r = idx >> 4, c4 = (idx & 15) * 4;
            tile[r * 65 + c4] = v[i][0]; tile[r * 65 + c4 + 1] = v[i][1]; tile[r * 65 + c4 + 2] = v[i][2]; tile[r * 65 + c4 + 3] = v[i][3]; }
        __syncthreads();
        const int t4n = t4 + (int)gridDim.x; const bool more = t4n < 3968;
        PrepItem qn = q;
        if (more) { qn = prep_item(p, Wb, layer, t4n);
#pragma unroll
            for (int i = 0; i < 8; ++i) { const int idx = tid + i * 512, r = idx >> 4, c4 = (idx & 15) * 4; v[i] = *(const f32x4*)(qn.src + (size_t)(qn.tk * 64 + r) * qn.N + qn.tn * 64 + c4); } }
        { const int n = tid & 63, kq = tid >> 6;
            int drow = q.tn * 64 + n;
            if (q.remap) { if (drow >= 6144) drow = 2048 + (drow - 6144); else if (drow >= 2048) drow = 7168 + (drow - 2048); }
            bf16_t* dp = q.dst + (size_t)drow * (q.ldk ? q.ldk : q.K) + q.koff + q.tk * 64 + kq * 32;
#pragma unroll
            for (int qq = 0; qq < 4; ++qq) { float f[8];
#pragma unroll
                for (int j = 0; j < 8; ++j) f[j] = tile[(kq * 32 + qq * 8 + j) * 65 + n];
                u32x4 w; w.x = pk2(f[0], f[1]); w.y = pk2(f[2], f[3]); w.z = pk2(f[4], f[5]); w.w = pk2(f[6], f[7]);
                *(u32x4*)(dp + qq * 8) = w; } }
        __syncthreads();
        if (!more) break;
        q = qn; t4 = t4n;
    }
}

__device__ void ada_partials(const Params& p, float* sl, int wv) {
    const int tid = ltid(wv); float* part = (float*)(p.ws + WS_PART);
    for (int u = blockIdx.x; u < 768; u += gridDim.x) {
        const int jb = u % 24, s = (u / 24) % 16, l = u / 384;
        __syncthreads();
        { const int b = tid >> 7, k = tid & 127; sl[tid] = silu_(p.c[b * D + s * 128 + k]); }
        __syncthreads();
        const int j = jb * 512 + tid;
        const float* w = p.w_ada + ((size_t)l * D + s * 128) * NADA + j;
        float a0 = 0.f, a1 = 0.f, a2 = 0.f, a3 = 0.f;
#pragma unroll 1
        for (int k0 = 0; k0 < 128; k0 += 16) { float wv[16];
#pragma unroll
            for (int k = 0; k < 16; ++k) wv[k] = w[(size_t)(k0 + k) * NADA];
#pragma unroll
            for (int k = 0; k < 16; ++k) { a0 += wv[k] * sl[k0 + k]; a1 += wv[k] * sl[128 + k0 + k]; a2 += wv[k] * sl[256 + k0 + k]; a3 += wv[k] * sl[384 + k0 + k]; } }
        float* po = part + (size_t)((s * 2 + l) * 4) * NADA + j;
        po[0] = a0; po[NADA] = a1; po[2 * NADA] = a2; po[3 * NADA] = a3;
    }
}

__device__ void cond_finalize(const Params& p, int wv) {
    const int gt = blockIdx.x * NTHR + ltid(wv), nt = gridDim.x * NTHR;
    const float* part = (const float*)(p.ws + WS_PART); float* cond = (float*)(p.ws + WS_COND); float* lb = (float*)(p.ws + WS_LB);
    for (int i = gt; i < 2 * 4 * NADA; i += nt) { const int l = i / (4 * NADA), rem = i % (4 * NADA), b = rem / NADA, j = rem % NADA;
        float a = p.b_ada[l * NADA + j];
#pragma unroll
        for (int s = 0; s < 16; ++s) a += part[(size_t)((s * 2 + l) * 4 + b) * NADA + j];
        cond[i] = a; }
    for (int i = gt; i < 2048; i += nt) { const int l = i >> 10, j = i & 1023;
        lb[i] = (l == 0) ? 0.f : 1.f / (1.f + __expf(p.lb_logits[j] - p.lb_logits[1024 + j])); }
}

__device__ __forceinline__ void rp_branch(f32x4 (&v)[8], const bf16_t* mbuf, const float* gp_, const float* gt_, int row, size_t cb, int lane) {
    f32x4 m[8]; float ss = 0.f;
#pragma unroll
    for (int i = 0; i < 8; ++i) { const u32x2 mw = *(const u32x2*)(mbuf + (size_t)row * D + 4 * lane + 256 * i); m[i] = (f32x4){bflo(mw.x), bfhi(mw.x), bflo(mw.y), bfhi(mw.y)}; ss += m[i][0] * m[i][0] + m[i][1] * m[i][1] + m[i][2] * m[i][2] + m[i][3] * m[i][3]; }
#pragma unroll
    for (int o = 32; o >= 1; o >>= 1) ss += shfl_xor_l(ss, lane, o);
    const float rs = rsqrtf(ss * (1.f / D) + EPS);
#pragma unroll
    for (int i = 0; i < 8; ++i) { const int c = 4 * lane + 256 * i;
        const f32x4 gp = *(const f32x4*)(gp_ + c), gg = *(const f32x4*)(gt_ + cb + c);
        v[i] = v[i] + gg * (m[i] * rs * gp); }
}
template <int KIND> __device__ void rowpass(const float* xres, const bf16_t* mix, const bf16_t* mlp, float* xout, bf16_t* hout, const float* gp1, const float* gt1, const float* gp2, const float* gt2,
                                            const float* gpre, const float* sc_, const float* sh_, int wv) {
    const int tid = ltid(wv), lane = tid & 63, wave = tid >> 6;
    const int nw = gridDim.x * 8;
    for (int row = blockIdx.x * 8 + wave; row < M; row += nw) {
        const int b = row >> 12; const size_t cb = (size_t)b * NADA;
        f32x4 v[8];
#pragma unroll
        for (int i = 0; i < 8; ++i) v[i] = *(const f32x4*)(xres + (size_t)row * D + 4 * lane + 256 * i);
        if (KIND >= 1) rp_branch(v, mix, gp1, gt1, row, cb, lane);
        if (KIND >= 2) { rp_branch(v, mlp, gp2, gt2, row, cb, lane);
#pragma unroll
            for (int i = 0; i < 8; ++i) *(f32x4*)(xout + (size_t)row * D + 4 * lane + 256 * i) = v[i]; }
        if (KIND != 2) {
            float ss = 0.f;
#pragma unroll
            for (int i = 0; i < 8; ++i) ss += v[i][0] * v[i][0] + v[i][1] * v[i][1] + v[i][2] * v[i][2] + v[i][3] * v[i][3];
#pragma unroll
            for (int o = 32; o >= 1; o >>= 1) ss += shfl_xor_l(ss, lane, o);
            const float rs = rsqrtf(ss * (1.f / D) + EPS);
#pragma unroll
            for (int i = 0; i < 8; ++i) { const int c = 4 * lane + 256 * i;
                const f32x4 gp = *(const f32x4*)(gpre + c), sc = *(const f32x4*)(sc_ + cb + c), sh = *(const f32x4*)(sh_ + cb + c);
                const f32x4 hh = (v[i] * rs * gp) * (1.f + sc) + sh;
                u32x2 w; w.x = pk2(hh[0], hh[1]); w.y = pk2(hh[2], hh[3]);
                *(u32x2*)(hout + (size_t)row * D + c) = w; }
        }
    }
}

template <bool DIAG> __device__ __forceinline__ void attn_tile(const bf16_t* Kb, const bf16_t* VT, const bf16x8 (&qf)[8], bf16x8 (&kf)[8], f32x16 (&o)[4], float& carry,
                                                              int tb, int s0, int hd, int tq, int h, int sg, bool more) {
    const float scale = 0.08838834764831845f * 1.4426950408889634f;
    f32x16 z = zero16();
#pragma unroll
    for (int c = 0; c < 8; ++c) z = MFMA32(kf[c], qf[c], z);
    bf16x8 vf[4][2];
#pragma unroll
    for (int e = 0; e < 4; ++e)
#pragma unroll
        for (int c2 = 0; c2 < 2; ++c2) vf[e][c2] = *(const bf16x8*)(VT + fm16_off(hd * 128 + 32 * e + tq, tb + s0 + 16 * c2 + 8 * h));
    if (more) { const bf16_t* kp = Kb + qk_off(tb + s0 - 32, hd, h, tq);
#pragma unroll
        for (int c = 0; c < 8; ++c) kf[c] = *(const bf16x8*)(kp + 512 * c); }
    float L[16];
#pragma unroll
    for (int i = 0; i < 16; ++i) { const int kl = 16 * (i >> 3) + 8 * h + (i & 7);
        const float zz = z[i] * scale; const float sp = fmaxf(zz, 0.f) + __builtin_amdgcn_logf(1.f + __builtin_amdgcn_exp2f(-fabsf(zz)));
        const bool valid = !DIAG || (kl < tq);
        L[i] = valid ? -sp : 0.f; z[i] = valid ? (zz - sp) : -1e30f; }
    float a = 0.f, bs = 0.f;
#pragma unroll
    for (int i = 0; i < 8; ++i) { a += L[i]; bs += L[8 + i]; }
    const float a2 = shfl_xor_l(a, tq | (h << 5), 32), b2 = shfl_xor_l(bs, tq | (h << 5), 32);
    float run = carry + bs + b2 + (h == 0 ? a2 : 0.f);
#pragma unroll
    for (int i = 7; i >= 0; --i) { z[i] = __builtin_amdgcn_exp2f(z[i] + run); run += L[i]; }
    run = carry + (h == 0 ? b2 : 0.f);
#pragma unroll
    for (int i = 15; i >= 8; --i) { z[i] = __builtin_amdgcn_exp2f(z[i] + run); run += L[i]; }
    carry += (a + a2) + (bs + b2);
    bf16x8 pf[2];
#pragma unroll
    for (int c2 = 0; c2 < 2; ++c2) { u32x4 w; w.x = pk2(z[8 * c2], z[8 * c2 + 1]); w.y = pk2(z[8 * c2 + 2], z[8 * c2 + 3]); w.z = pk2(z[8 * c2 + 4], z[8 * c2 + 5]); w.w = pk2(z[8 * c2 + 6], z[8 * c2 + 7]);
        pf[c2] = __builtin_bit_cast(bf16x8, w); }
#pragma unroll
    for (int e = 0; e < 4; ++e)
#pragma unroll
        for (int c2 = 0; c2 < 2; ++c2) o[e] = MFMA32(vf[e][c2], pf[c2], o[e]);
}

__device__ __forceinline__ void attn_item(const bf16_t* Q, const bf16_t* Kb, const bf16_t* VT, bf16_t* Y, int item, int lane) {
    const int qt = 127 - (item & 127), hd = (item >> 7) & 7, b = item >> 10;
    const int tq = lane & 31, h = lane >> 5;
    const int tb = b * T; const int t0 = qt * 32;
    const bf16_t* qp = Q + qk_off(tb + t0, hd, h, tq);
    bf16x8 qf[8];
#pragma unroll
    for (int c = 0; c < 8; ++c) qf[c] = *(const bf16x8*)(qp + 512 * c);
    f32x16 o[4];
#pragma unroll
    for (int e = 0; e < 4; ++e) o[e] = zero16();
    float carry = 0.f;
    const int sg = (tq & 19) | ((tq & 4) << 1) | ((tq & 8) >> 1);
    bf16x8 kf[8];
    { const bf16_t* kp = Kb + qk_off(tb + t0, hd, h, tq);
#pragma unroll
      for (int c = 0; c < 8; ++c) kf[c] = *(const bf16x8*)(kp + 512 * c); }
    attn_tile<true>(Kb, VT, qf, kf, o, carry, tb, t0, hd, tq, h, sg, qt > 0);
    for (int kt = qt - 1; kt >= 0; --kt) {
        if (__all(carry < -150.1f)) break;
        attn_tile<false>(Kb, VT, qf, kf, o, carry, tb, kt * 32, hd, tq, h, sg, kt > 0);
    }
    bf16_t* yp = Y + (unsigned)((tb + t0 + tq) * 2048 + hd * 128 + 4 * h);
#pragma unroll
    for (int e = 0; e < 4; ++e)
#pragma unroll
        for (int g = 0; g < 4; ++g) { u32x2 w; w.x = pk2(o[e][4 * g], o[e][4 * g + 1]); w.y = pk2(o[e][4 * g + 2], o[e][4 * g + 3]); *(u32x2*)(yp + 32 * e + 8 * g) = w; }
}

__device__ __forceinline__ void hg1_item(unsigned char* ws, LAS unsigned char* wl, int item, int lane) {
    const float* LOGFT = (const float*)(ws + R1_LOGFT); const bf16_t* QQT = (const bf16_t*)(ws + R1_QQT); const bf16_t* VHT = (const bf16_t*)(ws + R1_VHT);
    bf16_t* QG = (bf16_t*)(ws + R2_QG); bf16_t* KG = (bf16_t*)(ws + R2_KG); float* DEC = (float*)(ws + WS_DEC); bf16_t* ST = (bf16_t*)(ws + R3_ST);
    const int db = item & 3, ch = item >> 2;
    const int n = ch & 63, hd = (ch >> 6) & 7, b = ch >> 9;
    const int d = lane & 31, h = lane >> 5;
    const int f = hd * 128 + db * 32 + d;
    const int tk = b * T + n * 64;
    float G[64];
#pragma unroll
    for (int tt = 0; tt < 2; ++tt) { const float* lp = LOGFT + fm32_off(f, tk + 32 * tt);
#pragma unroll
        for (int i = 0; i < 8; ++i) { const f32x4 v = *(const f32x4*)(lp + 128 * i); G[32 * tt + 4 * i] = v[0]; G[32 * tt + 4 * i + 1] = v[1]; G[32 * tt + 4 * i + 2] = v[2]; G[32 * tt + 4 * i + 3] = v[3]; } }
    u32x4 qw[8];
#pragma unroll
    for (int tt = 0; tt < 2; ++tt)
#pragma unroll
        for (int i = 0; i < 4; ++i) qw[4 * tt + i] = *(const u32x4*)(QQT + fm16_off(f, tk + 32 * tt) + 256 * i);
    float ko[32];
#pragma unroll
    for (int c = 0; c < 4; ++c)
#pragma unroll
        for (int j = 0; j < 8; ++j) ko[8 * c + j] = 1.f - __builtin_amdgcn_exp2f((h ? G[16 * c + 8 + j] : G[16 * c + j]) * 1.4426950408889634f);
#pragma unroll
    for (int t = 1; t < 64; ++t) G[t] += G[t - 1];
    const float Gl2 = G[63] * 1.4426950408889634f;
    if (h == 0) DEC[(size_t)ch * 128 + db * 32 + d] = __builtin_amdgcn_exp2f(Gl2);
    bf16x8 af[4];
#pragma unroll
    for (int c = 0; c < 4; ++c) { float kdv[8];
#pragma unroll
        for (int j = 0; j < 8; ++j) {
            const float g2 = (h ? G[16 * c + 8 + j] : G[16 * c + j]) * 1.4426950408889634f;
            const unsigned qwv = h ? qw[2 * c + 1][j >> 1] : qw[2 * c][j >> 1];
            const float kk = ko[8 * c + j], qq = (j & 1) ? bfhi(qwv) : bflo(qwv);
            const float qg = qq * __builtin_amdgcn_exp2f(g2), kg = kk * __builtin_amdgcn_exp2f(fminf(-g2, 120.f));
            kdv[j] = kk * __builtin_amdgcn_exp2f(Gl2 - g2);
            LAS unsigned char* wp = wl + (c >> 1) * 4096 + ((16 * (c & 1) + j) * 32 + d) * 2 + h * 512;
            *(LAS bf16_t*)wp = (bf16_t)(pk2(qg, 0.f) & 0xffffu); *(LAS bf16_t*)(wp + 2048) = (bf16_t)(pk2(kg, 0.f) & 0xffffu); }
        u32x4 w; w.x = pk2(kdv[0], kdv[1]); w.y = pk2(kdv[2], kdv[3]); w.z = pk2(kdv[4], kdv[5]); w.w = pk2(kdv[6], kdv[7]); af[c] = __builtin_bit_cast(bf16x8, w); }
    {
        const int tt_ = lane >> 1, hf = lane & 1;
        asm volatile("" ::: "memory");
#pragma unroll
        for (int tile = 0; tile < 2; ++tile)
#pragma unroll
            for (int j = 0; j < 2; ++j) {
                const u32x4 qv = *(const LAS u32x4*)(wl + tile * 4096 + lane * 32 + j * 16), kv = *(const LAS u32x4*)(wl + tile * 4096 + 2048 + lane * 32 + j * 16);
                const int piece = db * 4 + 2 * hf + j;
                *(u32x4*)(QG + qk_off(tk + 32 * tile, hd, piece, tt_)) = qv; *(u32x4*)(KG + qk_off(tk + 32 * tile, hd, piece, swap23(tt_))) = kv; }
        asm volatile("" ::: "memory");
    }
#pragma unroll
    for (int e = 0; e < 4; ++e) { f32x16 acc = zero16();
        bf16x8 vf[4];
#pragma unroll
        for (int c = 0; c < 4; ++c) vf[c] = *(const bf16x8*)(VHT + fm16_off(hd * 128 + 32 * e + d, tk + 16 * c + 8 * h));
#pragma unroll
        for (int c = 0; c < 4; ++c) acc = MFMA32(af[c], vf[c], acc);
        bf16_t* sp = ST + (size_t)ch * 16384 + ((e * 16 + 4 * db) * 32 + d) * 8 + 4 * h;
#pragma unroll
        for (int g = 0; g < 4; ++g) { u32x2 w; w.x = pk2(acc[4 * g], acc[4 * g + 1]); w.y = pk2(acc[4 * g + 2], acc[4 * g + 3]); *(u32x2*)(sp + 256 * g) = w; } }
}

__device__ void hg2_scan(unsigned char* ws, int wv) {
    bf16_t* ST = (bf16_t*)(ws + R3_ST); const float* DEC = (const float*)(ws + WS_DEC);
    const int gt = blockIdx.x * NTHR + ltid(wv), nt = gridDim.x * NTHR;
    for (int i = gt; i < 32 * 128 * 32; i += nt) {
        const int gi = i & 4095, bh = i >> 12;
        const int d0 = ((gi >> 6) & 15) * 8 + (gi & 1) * 4;
        float s0 = 0.f, s1 = 0.f, s2 = 0.f, s3 = 0.f;
        bf16_t* sp = ST + (size_t)bh * 64 * 16384 + 4 * gi;
        const float* dp = DEC + (size_t)bh * 64 * 128 + d0;
        u32x2 wb[16]; f32x4 db[16];
#pragma unroll
        for (int k = 0; k < 16; ++k) { wb[k] = *(const u32x2*)(sp + (size_t)k * 16384); db[k] = *(const f32x4*)(dp + k * 128); }
#pragma unroll 1
        for (int n0 = 0; n0 < 64; n0 += 16) {
#pragma unroll
            for (int k = 0; k < 16; ++k) { const int n = n0 + k;
                const u32x2 w = wb[k]; const f32x4 dc = db[k];
                if (n0 + 16 < 64) { wb[k] = *(const u32x2*)(sp + (size_t)(n + 16) * 16384); db[k] = *(const f32x4*)(dp + (n + 16) * 128); }
                u32x2 o; o.x = pk2(s0, s1); o.y = pk2(s2, s3); *(u32x2*)(sp + (size_t)n * 16384) = o;
                s0 = dc[0] * s0 + bflo(w.x); s1 = dc[1] * s1 + bfhi(w.x); s2 = dc[2] * s2 + bflo(w.y); s3 = dc[3] * s3 + bfhi(w.y); }
        }
    }
}

__device__ __forceinline__ void hg3_item(unsigned char* ws, const float* ghg, int item, int lane) {
    const bf16_t* QG = (const bf16_t*)(ws + R2_QG); const bf16_t* KG = (const bf16_t*)(ws + R2_KG); const bf16_t* VHT = (const bf16_t*)(ws + R1_VHT);
    const bf16_t* ST = (const bf16_t*)(ws + R3_ST); const bf16_t* SHG = (const bf16_t*)(ws + R4_SHG); bf16_t* Y = (bf16_t*)(ws + HB_YHG);
    const int th = (item ^ (item >> 11)) & 1, ch = item >> 1;
    const int n = ch & 63, hd = (ch >> 6) & 7, b = ch >> 9;
    const int tq = lane & 31, h = lane >> 5;
    const int tk = b * T + n * 64;
    const bf16_t* qp = QG + qk_off(tk + 32 * th, hd, h, tq);
    bf16x8 qf[8];
#pragma unroll
    for (int c = 0; c < 8; ++c) qf[c] = *(const bf16x8*)(qp + 512 * c);
    f32x16 o[4];
#pragma unroll
    for (int e = 0; e < 4; ++e) o[e] = zero16();
    for (int st = 0; st <= th; ++st) {
        const bf16_t* kp = KG + qk_off(tk + 32 * st, hd, h, tq);
        f32x16 z = zero16();
#pragma unroll
        for (int c = 0; c < 8; ++c) z = MFMA32(*(const bf16x8*)(kp + 512 * c), qf[c], z);
        const bool diag = (st == th);
        bf16x8 pf[2];
#pragma unroll
        for (int c2 = 0; c2 < 2; ++c2) { float s[8];
#pragma unroll
            for (int j = 0; j < 8; ++j) { const int kl = 16 * c2 + 8 * h + j; s[j] = (!diag || kl <= tq) ? z[8 * c2 + j] : 0.f; }
            u32x4 w; w.x = pk2(s[0], s[1]); w.y = pk2(s[2], s[3]); w.z = pk2(s[4], s[5]); w.w = pk2(s[6], s[7]); pf[c2] = __builtin_bit_cast(bf16x8, w); }
#pragma unroll
        for (int e = 0; e < 4; ++e)
#pragma unroll
            for (int c2 = 0; c2 < 2; ++c2) o[e] = MFMA32(*(const bf16x8*)(VHT + fm16_off(hd * 128 + 32 * e + tq, tk + 32 * st + 16 * c2 + 8 * h)), pf[c2], o[e]);
    }
#pragma unroll
    for (int e = 0; e < 4; ++e) {
        const bf16_t* sp = ST + (size_t)ch * 16384 + ((e * 16 + h) * 32 + tq) * 8;
#pragma unroll
        for (int c = 0; c < 8; ++c) o[e] = MFMA32(*(const bf16x8*)(sp + 512 * c), qf[c], o[e]); }
    float ss = 0.f;
#pragma unroll
    for (int e = 0; e < 4; ++e)
#pragma unroll
        for (int i = 0; i < 16; ++i) ss += o[e][i] * o[e][i];
    ss += shfl_xor_l(ss, lane, 32);
    const float rs = rsqrtf(ss * (1.f / 128.f) + EPS);
    const size_t tokr = (size_t)(tk + 32 * th + tq);
#pragma unroll
    for (int e = 0; e < 4; ++e)
#pragma unroll
        for (int g = 0; g < 4; ++g) { const int e0 = 32 * e + 8 * g;
            const f32x4 gn = *(const f32x4*)(ghg + hd * 128 + 4 * h + e0); const u32x2 gw = *(const u32x2*)(SHG + tokr * 1024 + hd * 128 + 4 * h + e0);
            u32x2 w; w.x = pk2(o[e][4 * g] * rs * gn[0] * bflo(gw.x), o[e][4 * g + 1] * rs * gn[1] * bfhi(gw.x));
            w.y = pk2(o[e][4 * g + 2] * rs * gn[2] * bflo(gw.y), o[e][4 * g + 3] * rs * gn[3] * bfhi(gw.y));
            *(u32x2*)(Y + 2 * tokr * 1024 + hd * 128 + 4 * h + e0) = w; }
}

__global__ void __launch_bounds__(NTHR, 2) fwd_kernel(Params p) {
    extern __shared__ __attribute__((aligned(16))) unsigned char lds_raw[];
    LAS unsigned char* lds = (LAS unsigned char*)lds_raw;
    float* ldsf = (float*)lds_raw;
    cg::grid_group grid = cg::this_grid();
    unsigned char* ws = p.ws;
    const int nw = gridDim.x * 8;
    bf16_t* Wb = (bf16_t*)(ws + WS_W); bf16_t* HB = (bf16_t*)(ws + WS_HB);
    const float* cond = (const float*)(ws + WS_COND);
    unsigned* bar = (unsigned*)(ws + WS_BAR); volatile LAS unsigned* bst = (volatile LAS unsigned*)(lds + LDS_BYTES);

    const int wv = __builtin_amdgcn_readfirstlane(threadIdx.x >> 6);
    if (threadIdx.x == 0) { bst[0] = 0u; bst[1] = 0u; (void)xb_add(&bar[XB_XCNT(xb_xcc_id())], 1u); }
    __syncthreads();
    prep_weights(p, 0, ldsf, wv);
    ada_partials(p, ldsf, wv);
    if (p.ws == nullptr) grid.sync();
    grid_bar(bar, bst, wv);
    cond_finalize(p, wv);
    grid_bar(bar, bst, wv);
    rowpass<0>(p.x, nullptr, nullptr, nullptr, HB, nullptr, nullptr, nullptr, nullptr, p.g_pre_mix, cond + 2048, cond, wv);
    grid_bar(bar, bst, wv);
#pragma clang loop unroll(disable)
    for (int l = 0; l < 2; ++l) {
        const float* condl = cond + (size_t)l * 4 * NADA;
        run_gemm<1, GSTAG>(lds, HB, Wb + W_IN, M, NG1, D, ws, nullptr, wv);
        run_gemm<2>(lds, Wb + W_IN + (size_t)NG1 * D, HB, NG2, M, D, ws, (const float*)(ws + WS_LB) + l * 1024, wv);
        grid_bar(bar, bst, wv);
        { const int tid = ltid(wv), lane = tid & 63, gw = blockIdx.x * 8 + (tid >> 6);
          for (int it = gw; it < 4096; it += nw) attn_item((const bf16_t*)(ws + R1_Q), (const bf16_t*)(ws + R1_K), (const bf16_t*)(ws + R1_VT), (bf16_t*)(ws + HB_YSB), it, lane); }
        { const int tid = ltid(wv), lane = tid & 63, gw = blockIdx.x * 8 + (tid >> 6);
          LAS unsigned char* wl = lds + (tid >> 6) * 8192;
          for (int it = gw; it < 8192; it += nw) hg1_item(ws, wl, it, lane); }
        grid_bar(bar, bst, wv);
        hg2_scan(ws, wv);
        grid_bar(bar, bst, wv);
        { const int tid = ltid(wv), lane = tid & 63, gw = blockIdx.x * 8 + (tid >> 6);
        for (int it = gw; it < 4096; it += nw) hg3_item(ws, p.g_hg + l * 1024, it, lane); }
        grid_bar(bar, bst, wv);
        run_gemm<4, GSTAG>(lds, HB, Wb + W_SB, M, D, D, ws, nullptr, wv);
        grid_bar(bar, bst, wv);
        run_gemm<5, GSTAG>(lds, (const bf16_t*)(ws + R2_MERGED), Wb + W_OUT, M, D, D, ws, nullptr, wv);
        grid_bar(bar, bst, wv);
        rowpass<1>(l == 0 ? p.x : p.out, (const bf16_t*)(ws + R3_MIX), nullptr, nullptr, HB, p.g_post_mix + l * D, condl + 2 * D, nullptr, nullptr, p.g_pre_mlp + l * D, condl + 4 * D, condl + 3 * D, wv);
        grid_bar(bar, bst, wv);
        run_gemm<6, GSTAG>(lds, HB, Wb + W_UP, M, FF, D, ws, nullptr, wv);
        grid_bar(bar, bst, wv);
        run_gemm<5, GSTAG>(lds, (const bf16_t*)(ws + R1_U), Wb + W_DN, M, D, FF, ws, (const float*)ws  , wv);
        grid_bar(bar, bst, wv);
        if (l == 0) {
            const float* cond1 = cond + (size_t)4 * NADA;
            rowpass<3>(p.x, (const bf16_t*)(ws + R3_MIX), (const bf16_t*)(ws + R3_MLP), p.out, HB, p.g_post_mix, condl + 2 * D, p.g_post_mlp, condl + 5 * D, p.g_pre_mix + D, cond1 + D, cond1, wv);
            prep_weights(p, 1, ldsf, wv);
            grid_bar(bar, bst, wv);
        } else {
            rowpass<2>(p.out, (const bf16_t*)(ws + R3_MIX), (const bf16_t*)(ws + R3_MLP), p.out, nullptr, p.g_post_mix + D, condl + 2 * D, p.g_post_mlp + D, condl + 5 * D, nullptr, nullptr, nullptr, wv);
        }
    }
}

extern "C" void kernel_launch(void* const* d_in, const int* in_sizes, int n_in, void* d_out, int out_size, void* d_ws, size_t ws_size, hipStream_t stream) {
    static int grid = 0;
    if (grid == 0) {
        if (n_in != 16 || out_size != M * D || ws_size < WS_END) { fprintf(stderr, "kernel_launch: unexpected shapes: n_in %d out %d ws %zu (need %zu)\n", n_in, out_size, ws_size, (size_t)WS_END); grid = -1; return; }
        int dev = 0, cus = 0, per_cu = 0;
        hipGetDevice(&dev); hipDeviceGetAttribute(&cus, hipDeviceAttributeMultiprocessorCount, dev);
        if (hipFuncSetAttribute((const void*)fwd_kernel, hipFuncAttributeMaxDynamicSharedMemorySize, LDS_BYTES + 64) != hipSuccess) { fprintf(stderr, "kernel_launch: hipFuncSetAttribute failed\n"); grid = -1; return; }
        hipOccupancyMaxActiveBlocksPerMultiprocessor(&per_cu, (const void*)fwd_kernel, NTHR, LDS_BYTES + 64);
        (void)hipGetLastError();
        if (per_cu < 1) { fprintf(stderr, "kernel_launch: occupancy query says %d blocks per CU\n", per_cu); per_cu = 1; }
        grid = cus;
    }
    if (grid < 0) return;
    Params p{};
    p.x = (const float*)d_in[0]; p.c = (const float*)d_in[1]; p.w_ada = (const float*)d_in[2]; p.b_ada = (const float*)d_in[3]; p.g_pre_mix = (const float*)d_in[4]; p.g_post_mix = (const float*)d_in[5];
    p.w_in = (const float*)d_in[6]; p.lb_logits = (const float*)d_in[7]; p.g_hg = (const float*)d_in[8]; p.w_sb = (const float*)d_in[9]; p.w_hg = (const float*)d_in[10]; p.w_out = (const float*)d_in[11];
    p.g_pre_mlp = (const float*)d_in[12]; p.g_post_mlp = (const float*)d_in[13]; p.w_up = (const float*)d_in[14]; p.w_dn = (const float*)d_in[15];
    p.out = (float*)d_out; p.ws = (unsigned char*)d_ws;
    if (hipMemsetAsync((char*)d_ws + WS_BAR, 0, XCD_BAR_WORDS * 4, stream) != hipSuccess) { fprintf(stderr, "kernel_launch: memset failed\n"); return; }
    void* args[] = {&p};
    hipError_t e = hipLaunchCooperativeKernel((const void*)fwd_kernel, dim3(grid), dim3(NTHR), args, LDS_BYTES + 64, stream);
    if (e != hipSuccess) fprintf(stderr, "kernel_launch: cooperative launch failed: %s (grid %d)\n", hipGetErrorString(e), grid);
}
```

```cpp
#include <hip/hip_runtime.h>
#include <hip/hip_cooperative_groups.h>
#include <cstdio>
namespace cg = cooperative_groups;

namespace pg8 {
#define PG8_LAS __attribute__((address_space(3)))
typedef unsigned short bf16_t;
typedef short bf16x8 __attribute__((ext_vector_type(8)));
typedef float f32x4 __attribute__((ext_vector_type(4)));
typedef unsigned u32x4 __attribute__((ext_vector_type(4)));
constexpr int BM = 256, BK = 64, HALF = 128, HTB = HALF * BK * 2  , STAGE_BYTES = 8 * HTB, NXCD = 8, WGM = 4;

__host__ __device__ __forceinline__ int lds_byte(int r, int c) { const int st = (r >> 4) * 2 + (c >> 5), rr = r & 15, cc = c & 31, ob = rr * 64 + cc * 2; return st * 1024 + (ob ^ (((ob >> 9) & 1) << 5)); }
__host__ __device__ __forceinline__ void stage_rc(int b, int& R, int& C) { const int st = b / 1024, sb = b % 1024, swz = sb ^ (((sb >> 9) & 1) << 5); R = (st >> 1) * 16 + swz / 64; C = (st & 1) * 32 + (swz % 64) / 2; }
__host__ __device__ __forceinline__ int perm32(int rho) { const int n = rho >> 4, i = rho & 15; return 8 * (i >> 2) + 4 * n + (i & 3); }

struct Unit { int pm, pn; };
struct Gemm { const bf16_t* A; const bf16_t* Bt; int M, N, K; };

struct StaticOrder {
    int nM, nN, nwg, G, c, wgm;
    __host__ __device__ void init(int M, int N, int G_, int c_) { nM = M / BM; nN = N / BM; nwg = nM * nN; G = G_; c = c_; wgm = WGM; }
    __host__ __device__ bool next(int i, Unit& u) const {
        const long L = (long)i * G + c; if (L >= nwg) return false;
        int wgid = (int)L; { const int q = nwg / NXCD, r = nwg % NXCD, xcd = wgid % NXCD, off = wgid / NXCD; wgid = (xcd < r ? xcd * (q + 1) : r * (q + 1) + (xcd - r) * q) + off; }
        const int nig = wgm * nN, gid = wgid / nig, fm = gid * wgm, gsz = (nM - fm) < wgm ? (nM - fm) : wgm;
        u.pm = fm + ((wgid % nig) % gsz); u.pn = (wgid % nig) / gsz; return true;
    }
    __device__ __forceinline__ void a_ready(const Unit&) const {}
    __device__ __forceinline__ void done(const Unit&) const {}
};
__device__ __forceinline__ unsigned cvt_pk_bf16(float lo, float hi) { unsigned r; asm volatile("v_cvt_pk_bf16_f32 %0, %1, %2" : "=v"(r) : "v"(lo), "v"(hi)); return r; }
template <class Epi, class Sched, bool STAMP = false>
__device__ __forceinline__ void gemm_phase(PG8_LAS unsigned char* lds, const Gemm g, const Sched& S, const Epi& E, unsigned long long* stamps) {
    unsigned ones_l = ~0u; asm volatile("" : "+s"(ones_l)); const int tid_l = (S.wv << 6) | (int)__builtin_amdgcn_mbcnt_hi(ones_l, __builtin_amdgcn_mbcnt_lo(ones_l, 0u));
    const int tid = tid_l, wid = __builtin_amdgcn_readfirstlane(tid >> 6), lane = tid & 63, wr = wid >> 2, wc = wid & 3, fr = lane & 15, fq = lane >> 4;
    const int K = g.K, nt = K / BK;
    int ts_lo = 0, ts_hi = 0, nts = 0; const unsigned long long rt_entry = STAMP ? (unsigned long long)wall_clock64() : 0ull;
#define PG8_STAMP() do { if (STAMP && wid == 0 && nts < 64) { const unsigned long long _c = (unsigned long long)clock64(); \
        ts_lo = (lane == nts) ? (int)(unsigned)_c : ts_lo; ts_hi = (lane == nts) ? (int)(unsigned)(_c >> 32) : ts_hi; ++nts; } } while (0)
    PG8_STAMP();
    unsigned voffA[2], voffB[2];
#pragma unroll
    for (int i = 0; i < 2; ++i) { int R, C; stage_rc(tid * 16 + i * 8192, R, C); const int Rb = Epi::PERM ? ((R & ~31) + perm32(R & 31)) : R;
        voffA[i] = (unsigned)(R * K + C) * 2u; voffB[i] = (unsigned)(Rb * K + C) * 2u; }
    const size_t kstep = (size_t)(BK * 2);
    const size_t hstep = (size_t)HALF * K * 2;
    const size_t tstep = 2 * hstep;
    const unsigned ldsw = (unsigned)wid * 1024u;
    const int aoff = lds_byte(wr * 64 + fr, fq * 8), boff = lds_byte(wc * 32 + fr, fq * 8);
#define PG8_SA(b, h) (((b) * 2 + (h)) * HTB)
#define PG8_SB(b, h) ((4 + (b) * 2 + (h)) * HTB)
#define PG8_STAGE(bufoff, gbase, voff) do { _Pragma("unroll") for (int _i = 0; _i < 2; ++_i) \
        __builtin_amdgcn_global_load_lds((const unsigned*)((const char*)(gbase) + (voff)[_i]), (PG8_LAS unsigned*)(lds + (bufoff) + ldsw + _i * 8192), 16, 0, 0); } while (0)
#define PG8_LDA(dst, b, h) do { _Pragma("unroll") for (int m = 0; m < 4; ++m) _Pragma("unroll") for (int k = 0; k < 2; ++k) dst[m][k] = *(const PG8_LAS bf16x8*)(lds + PG8_SA(b, h) + aoff + m * 2048 + k * 1024); } while (0)
#define PG8_LDB(dst, b, h) do { _Pragma("unroll") for (int n = 0; n < 2; ++n) _Pragma("unroll") for (int k = 0; k < 2; ++k) dst[n][k] = *(const PG8_LAS bf16x8*)(lds + PG8_SB(b, h) + boff + n * 2048 + k * 1024); } while (0)
#define PG8_MMA(ai, bj, At, Bt) do { __builtin_amdgcn_s_setprio(1); _Pragma("unroll") for (int m = 0; m < 4; ++m) _Pragma("unroll") for (int n = 0; n < 2; ++n) _Pragma("unroll") for (int k = 0; k < 2; ++k) \
        acc[ai][bj][m][n] = __builtin_amdgcn_mfma_f32_16x16x32_bf16(Bt[n][k], At[m][k], acc[ai][bj][m][n], 0, 0, 0); __builtin_amdgcn_s_setprio(0); } while (0)
#define PG8_WAIT_V(n) asm volatile("s_waitcnt vmcnt(" #n ")" ::: "memory")
#define PG8_WAIT_L(n) asm volatile("s_waitcnt lgkmcnt(" #n ")" ::: "memory")
#define PG8_BAR __builtin_amdgcn_s_barrier()
#define PG8_SCHED __builtin_amdgcn_sched_barrier(0)
    Unit cur, nxt; int ui = 0;
    if (!S.next(0, cur)) return;
    f32x4 acc[2][2][4][2];
#pragma unroll
    for (int a = 0; a < 2; ++a)
#pragma unroll
        for (int b = 0; b < 2; ++b)
#pragma unroll
            for (int m = 0; m < 4; ++m)
#pragma unroll
                for (int n = 0; n < 2; ++n) acc[a][b][m][n] = (f32x4){0.f, 0.f, 0.f, 0.f};
    bf16x8 At[4][2], B0[2][2], B1[2][2];
    const char* cA = (const char*)g.A + (size_t)cur.pm * tstep; const char* cB = (const char*)g.Bt + (size_t)cur.pn * tstep;
    S.a_ready(cur);
    PG8_STAGE(PG8_SB(0, 0), cB, voffB); PG8_STAGE(PG8_SA(0, 0), cA, voffA); PG8_STAGE(PG8_SB(0, 1), cB + hstep, voffB); PG8_STAGE(PG8_SA(0, 1), cA + hstep, voffA);
    if (wr == 1) PG8_BAR;
    PG8_WAIT_V(4); PG8_BAR;
    PG8_STAGE(PG8_SB(1, 0), cB + kstep, voffB); PG8_STAGE(PG8_SA(1, 0), cA + kstep, voffA); PG8_STAGE(PG8_SB(1, 1), cB + hstep + kstep, voffB);
    PG8_WAIT_V(6); PG8_BAR;
    PG8_STAMP();
    for (;;) {
        const bool has_next = S.next(ui + 1, nxt);
        const char* nA = has_next ? (const char*)g.A + (size_t)nxt.pm * tstep : cA; const char* nB = has_next ? (const char*)g.Bt + (size_t)nxt.pn * tstep : cB;
        for (int t = 0; t < nt; t += 2) {
            const bool last = (t == nt - 2);
            const char* a1 = cA + (size_t)(t + 1) * kstep;
            const char* a2 = last ? nA : cA + (size_t)(t + 2) * kstep; const char* b2 = last ? nB : cB + (size_t)(t + 2) * kstep;
            const char* a3 = a2 + kstep; const char* b3 = b2 + kstep;
            if (last && has_next) S.a_ready(nxt);
            if constexpr (Epi::MID) { if (t == (nt >> 1)) E.mid(acc, cur, wr, wc, fr, fq); }
            PG8_LDB(B0, 0, 0); PG8_SCHED; PG8_LDA(At, 0, 0); PG8_STAGE(PG8_SA(1, 1), a1 + hstep, voffA);
            PG8_WAIT_L(8); PG8_BAR; PG8_WAIT_L(0); PG8_MMA(0, 0, At, B0); PG8_BAR; PG8_SCHED;
            PG8_LDB(B1, 0, 1); PG8_STAGE(PG8_SB(0, 0), b2, voffB);
            PG8_BAR; PG8_WAIT_L(0); PG8_MMA(0, 1, At, B1); PG8_BAR;
            PG8_LDA(At, 0, 1); PG8_STAGE(PG8_SA(0, 0), a2, voffA);
            PG8_BAR; PG8_WAIT_L(0); PG8_MMA(1, 0, At, B0); PG8_BAR; PG8_SCHED;
            PG8_STAGE(PG8_SB(0, 1), b2 + hstep, voffB);
            PG8_WAIT_V(6); PG8_BAR; PG8_MMA(1, 1, At, B1); PG8_BAR;
            PG8_LDB(B0, 1, 0); PG8_SCHED; PG8_LDA(At, 1, 0); PG8_STAGE(PG8_SA(0, 1), a2 + hstep, voffA);
            PG8_WAIT_L(8); PG8_BAR; PG8_WAIT_L(0); PG8_MMA(0, 0, At, B0); PG8_BAR; PG8_SCHED;
            PG8_LDB(B1, 1, 1); PG8_STAGE(PG8_SB(1, 0), b3, voffB);
            PG8_BAR; PG8_WAIT_L(0); PG8_MMA(0, 1, At, B1); PG8_BAR;
            PG8_LDA(At, 1, 1); PG8_STAGE(PG8_SA(1, 0), a3, voffA);
            PG8_BAR; PG8_WAIT_L(0); PG8_MMA(1, 0, At, B0); PG8_BAR; PG8_SCHED;
            PG8_STAGE(PG8_SB(1, 1), b3 + hstep, voffB);
            PG8_WAIT_V(6); PG8_BAR; PG8_MMA(1, 1, At, B1); PG8_BAR;
        }
        PG8_STAMP();
        if constexpr (!Epi::AFTER_DRAIN) { E(acc, cur, wr, wc, fr, fq); S.done(cur); }
        PG8_STAMP();
        if (!has_next) break;
#pragma unroll
        for (int a = 0; a < 2; ++a)
#pragma unroll
            for (int b = 0; b < 2; ++b)
#pragma unroll
                for (int m = 0; m < 4; ++m)
#pragma unroll
                    for (int n = 0; n < 2; ++n) acc[a][b][m][n] = (f32x4){0.f, 0.f, 0.f, 0.f};
        cur = nxt; cA = nA; cB = nB; ++ui;
    }
    PG8_WAIT_V(0);
    if (wr == 0) PG8_BAR;
    PG8_BAR;
    if constexpr (Epi::AFTER_DRAIN) { E.fused(acc, cur, wr, wc, fr, fq, lds, wid, lane); S.done(cur); }
    PG8_STAMP();
    if (STAMP && wid == 0) { stamps[lane] = lane < nts ? (((unsigned long long)(unsigned)ts_hi << 32) | (unsigned)ts_lo) : 0ull;
        if (lane == 62) stamps[62] = rt_entry; if (lane == 63) stamps[63] = (unsigned long long)wall_clock64(); }
#undef PG8_STAMP
#undef PG8_SA
#undef PG8_SB
#undef PG8_STAGE
#undef PG8_LDA
#undef PG8_LDB
#undef PG8_MMA
#undef PG8_WAIT_V
#undef PG8_WAIT_L
#undef PG8_BAR
#undef PG8_SCHED
}
}

using pg8::bf16_t; using pg8::bf16x8; using pg8::f32x4; using pg8::u32x4;
typedef float f32x16 __attribute__((ext_vector_type(16)));
typedef float f32x2 __attribute__((ext_vector_type(2)));
typedef unsigned u32x2 __attribute__((ext_vector_type(2)));
typedef __bf16 bf2_t __attribute__((ext_vector_type(2)));
#define LAS PG8_LAS
#define MFMA32(a, b, c) __builtin_amdgcn_mfma_f32_32x32x16_bf16((a), (b), (c), 0, 0, 0)

constexpr int D = 2048, NB = 4, T = 4096, M = NB * T, FF = 8192, NADA = 6 * D;
constexpr int NG1 = 7168, NG2 = 4096;
constexpr float EPS = 1e-6f;
constexpr int NTHR = 512, LDS_BYTES = 131072;
#ifndef G2WGM
#define G2WGM 16
#endif
#ifndef GSTAG
#define GSTAG 0
#endif
constexpr size_t MiB = (size_t)1 << 20;
constexpr size_t W_IN = 0, W_SB = 23068672, W_HG = W_SB + 2097152, W_OUT = W_HG + 2097152, W_UP = W_OUT + 4194304, W_DN = W_UP + 16777216;
constexpr size_t WS_W = 0, WS_HB = 124 * MiB, WS_R1 = 188 * MiB, WS_R2 = 444 * MiB, WS_R3 = 508 * MiB, WS_R4 = 636 * MiB, WS_R5 = 668 * MiB, WS_SM = 796 * MiB;
constexpr size_t WS_PART = WS_SM, WS_COND = WS_SM + 6 * MiB, WS_LB = WS_COND + 393216, WS_BAR = WS_COND + 512 * 1024, WS_DEC = WS_SM + 7 * MiB, WS_END = WS_SM + 9 * MiB;
constexpr size_t R1_Q = WS_R1, R1_K = WS_R1 + 32 * MiB, R1_VT = WS_R1 + 64 * MiB, R1_QQT = WS_R1 + 96 * MiB, R1_KKT = WS_R1 + 128 * MiB, R1_VHT = WS_R1 + 160 * MiB, R1_LOGFT = WS_R1 + 192 * MiB;
constexpr size_t R1_PBUF = WS_R1, R1_U = WS_R1;
constexpr size_t R2_QG = WS_R2, R2_KG = WS_R2 + 32 * MiB, R2_MERGED = WS_R2;
constexpr size_t R3_ST = WS_R3, R3_MIX = WS_R3, R3_MLP = WS_R3 + 64 * MiB;
constexpr size_t R4_SHG = WS_R4, R5_SGA = WS_R5, R5_SGB = WS_R5 + 64 * MiB;
constexpr size_t HB_YSB = WS_HB, HB_YHG = WS_HB + 2048;

struct WvOrder : pg8::StaticOrder { int wv, rot;
    __device__ __forceinline__ bool next(int i, pg8::Unit& u) const { if (!pg8::StaticOrder::next(i, u)) return false; if (rot) u.pm = (u.pm + rot * i) % nM; return true; } };
struct Params {
    const float* x; const float* c; const float* w_ada; const float* b_ada; const float* g_pre_mix; const float* g_post_mix; const float* w_in; const float* lb_logits;
    const float* g_hg; const float* w_sb; const float* w_hg; const float* w_out; const float* g_pre_mlp; const float* g_post_mlp; const float* w_up; const float* w_dn;
    float* out; unsigned char* ws;
};

__device__ __forceinline__ unsigned pk2(float a, float b) { f32x2 v = {a, b}; bf2_t r = __builtin_convertvector(v, bf2_t); return __builtin_bit_cast(unsigned, r); }
__device__ __forceinline__ float bflo(unsigned w) { return __uint_as_float(w << 16); }
__device__ __forceinline__ float bfhi(unsigned w) { return __uint_as_float(w & 0xffff0000u); }
__device__ __forceinline__ float sigm(float x) { return __builtin_amdgcn_rcpf(1.f + __builtin_amdgcn_exp2f(x * -1.4426950408889634f)); }
__device__ __forceinline__ float silu_(float x) { return x * __builtin_amdgcn_rcpf(1.f + __builtin_amdgcn_exp2f(x * -1.4426950408889634f)); }
__device__ __forceinline__ int ltid(int wv) { unsigned ones = ~0u; asm volatile("" : "+s"(ones));
    return (wv << 6) | (int)__builtin_amdgcn_mbcnt_hi(ones, __builtin_amdgcn_mbcnt_lo(ones, 0u)); }
#define XB_TMO      128
#define XB_XCNT(j)  (256  + 64 * (j))
#define XB_XSUB(j)  (1280 + 64 * (j))
#define XB_XGEN(j)  (2304 + 64 * (j))
#define XB_TOP      3328
#define XB_TOPGEN   3392
#define XCD_BAR_WORDS 3456
#define XB_SPIN_CAP (1u << 22)
__device__ __forceinline__ unsigned xb_ld(unsigned* p)              { return __hip_atomic_load(p, __ATOMIC_RELAXED, __HIP_MEMORY_SCOPE_AGENT); }
__device__ __forceinline__ unsigned xb_add(unsigned* p, unsigned v) { return __hip_atomic_fetch_add(p, v, __ATOMIC_RELAXED, __HIP_MEMORY_SCOPE_AGENT); }
__device__ __forceinline__ unsigned xb_xcc_id() { return (unsigned)__builtin_amdgcn_s_getreg((3 << 11) | 20) & 0xFu; }
#define XB_SPIN(cond, bar) do { unsigned _sp = 0; while (cond) { __builtin_amdgcn_s_sleep(1); \
    if ((++_sp & 255u) == 0u) { if (xb_ld(&(bar)[XB_TMO])) break; if (_sp > XB_SPIN_CAP) { atomicAdd(&(bar)[XB_TMO], 1u); break; } } } } while (0)
__device__ __forceinline__ void xcd_barrier_complete(unsigned* bar, unsigned x, unsigned& nloc, unsigned& nx) {
    const unsigned G = gridDim.x;
    unsigned sum, cnt, mine, sp = 0u;
    for (;;) {
        sum = 0u; cnt = 0u; mine = 0u;
#pragma unroll
        for (unsigned j = 0; j < 16; ++j) { const unsigned c = xb_ld(&bar[XB_XCNT(j)]); sum += c; cnt += (c > 0u) ? 1u : 0u; mine = (j == x) ? c : mine; }
        if (sum == G) break;
        __builtin_amdgcn_s_sleep(1);
        if ((++sp & 255u) == 0u) { if (xb_ld(&bar[XB_TMO])) break; if (sp > XB_SPIN_CAP) { atomicAdd(&bar[XB_TMO], 1u); break; } }
    }
    nloc = mine > 0u ? mine : 1u; nx = cnt > 0u ? cnt : 1u;
}
__device__ __forceinline__ void grid_bar(unsigned* bar_in, volatile LAS unsigned* st, int wv) {
    unsigned* bar = bar_in; asm volatile("" : "+s"(bar));
    asm volatile("s_waitcnt vmcnt(0)" ::: "memory");
    __syncthreads();
    if (ltid(wv) == 0) {
        const unsigned x = xb_xcc_id();
        __builtin_amdgcn_s_waitcnt(0);
        unsigned nloc = st[0], nx = st[1];
        if (nloc == 0u) { xcd_barrier_complete(bar, x, nloc, nx); st[0] = nloc; st[1] = nx; }
        const unsigned old = xb_add(&bar[XB_XSUB(x)], 1u);
        const unsigned gen = old / nloc;
        if (old + 1u == (gen + 1u) * nloc) {
            __builtin_amdgcn_fence(__ATOMIC_RELEASE, "agent");
            asm volatile("s_waitcnt vmcnt(0)" ::: "memory");
            const unsigned og = xb_add(&bar[XB_TOP], 1u);
            const unsigned tg = og / nx;
            if (og + 1u == (tg + 1u) * nx) xb_add(&bar[XB_TOPGEN], 1u);
            else XB_SPIN(xb_ld(&bar[XB_TOPGEN]) == tg, bar);
            __builtin_amdgcn_fence(__ATOMIC_ACQUIRE, "agent");
            xb_add(&bar[XB_XGEN(x)], 1u);
            asm volatile("s_waitcnt vmcnt(0)" ::: "memory");
        } else {
            XB_SPIN(xb_ld(&bar[XB_XGEN(x)]) == gen, bar);
            __builtin_amdgcn_fence(__ATOMIC_ACQUIRE, "agent");
            asm volatile("s_waitcnt vmcnt(0)" ::: "memory");
        }
    }
    __syncthreads();
}
__device__ __forceinline__ float shfl_xor_l(float v, int lane, int o) { return __int_as_float(__builtin_amdgcn_ds_bpermute((lane ^ o) << 2, __float_as_int(v))); }
__device__ __forceinline__ unsigned fm16_off(int f, int tok) { return (unsigned)(((tok >> 5) * 32 + (f >> 5)) * 1024 + ((((tok & 31) >> 3) * 32 + (f & 31)) * 8) + (tok & 7)); }
__device__ __forceinline__ unsigned fm32_off(int f, int tok) { return (unsigned)(((tok >> 5) * 32 + (f >> 5)) * 1024 + ((((tok & 31) >> 2) * 32 + (f & 31)) * 4) + (tok & 3)); }
__device__ __forceinline__ int swap23(int m) { return (m & 19) | ((m & 4) << 1) | ((m & 8) >> 1); }
__device__ __forceinline__ unsigned qk_off(int tok, int hd, int piece, int slot) { return (unsigned)(((((tok >> 5) * 8 + hd) * 16 + piece) * 32 + slot) * 8); }
__device__ __forceinline__ f32x16 zero16() { f32x16 z; _Pragma("unroll") for (int i = 0; i < 16; ++i) z[i] = 0.f; return z; }

template <int MODE> struct Epi {
    static constexpr bool PERM = true, AFTER_DRAIN = false, MID = (MODE == 4);
    unsigned char* ws; const float* lb;
    __device__ __forceinline__ void mid(f32x4 (&acc)[2][2][4][2], const pg8::Unit& u, int wr, int wc, int fr, int fq) const {
        unsigned rc = (unsigned)((u.pm * 256 + wr * 64 + fr) * D + u.pn * 256 + wc * 32 + 8 * fq);
        asm volatile("" : "+v"(rc));
        const bf16_t* SGA = (const bf16_t*)(ws + R5_SGA); const bf16_t* SGB = (const bf16_t*)(ws + R5_SGB);
#pragma unroll
        for (int ai = 0; ai < 2; ++ai)
#pragma unroll
            for (int m = 0; m < 4; ++m) {
#pragma unroll
                for (int bj = 0; bj < 2; ++bj) { const unsigned off = rc + (unsigned)((ai * 128 + m * 16) * D + bj * 128);
                    const u32x4 ga = *(const u32x4*)(SGA + off), gb = *(const u32x4*)(SGB + off);
                    const float ra[8] = {bflo(ga.x), bfhi(ga.x), bflo(ga.y), bfhi(ga.y), bflo(ga.z), bfhi(ga.z), bflo(ga.w), bfhi(ga.w)};
                    const float rb[8] = {bflo(gb.x), bfhi(gb.x), bflo(gb.y), bfhi(gb.y), bflo(gb.z), bfhi(gb.z), bflo(gb.w), bfhi(gb.w)};
#pragma unroll
                    for (int j = 0; j < 8; ++j) acc[ai][bj][m][j >> 2][j & 3] *= ra[j] * __builtin_amdgcn_rcpf(fmaxf(rb[j], 1e-30f));
                }
                asm volatile("" ::: "memory"); }
    }
    __device__ __forceinline__ void operator()(const f32x4 (&acc)[2][2][4][2], const pg8::Unit& u, int wr, int wc, int fr, int fq) const {
        const int row0 = u.pm * 256 + wr * 64 + fr, col0 = u.pn * 256 + wc * 32 + 8 * fq;
        bf16_t* base1 = nullptr; int ld1 = 1024, act1 = 0, cb1 = 0;
        if (MODE == 1) { const int ct = u.pn * 256;
            if (ct < 1024) { base1 = (bf16_t*)(ws + R1_Q); }
            else if (ct < 2048) { base1 = (bf16_t*)(ws + R1_K); cb1 = 1024; }
            else if (ct < 3072) { base1 = (bf16_t*)(ws + R4_SHG); cb1 = 2048; act1 = 1; }
            else if (ct < 5120) { base1 = (bf16_t*)(ws + R5_SGA); cb1 = 3072; act1 = 2; ld1 = 2048; }
            else { base1 = (bf16_t*)(ws + R5_SGB); cb1 = 5120; act1 = 2; ld1 = 2048; } }
        const int rt2 = u.pm * 256;
#pragma unroll
        for (int ai = 0; ai < 2; ++ai)
#pragma unroll
            for (int m = 0; m < 4; ++m) { const int row = row0 + ai * 128 + m * 16;
                float lbv = 0.f; if (MODE == 2) { if (rt2 >= 2048 && rt2 < 3072) lbv = lb[row - 2048]; }
#pragma unroll
                for (int bj = 0; bj < 2; ++bj) { const int col = col0 + bj * 128; const f32x4 v0 = acc[ai][bj][m][0], v1 = acc[ai][bj][m][1];
                    float v[8] = {v0[0], v0[1], v0[2], v0[3], v1[0], v1[1], v1[2], v1[3]};
                    if (MODE == 1) {
                        if (act1 == 1) { _Pragma("unroll") for (int j = 0; j < 8; ++j) v[j] = silu_(v[j]); }
                        else if (act1 == 2) { _Pragma("unroll") for (int j = 0; j < 8; ++j) v[j] = sigm(v[j]); }
                        u32x4 w; w.x = pk2(v[0], v[1]); w.y = pk2(v[2], v[3]); w.z = pk2(v[4], v[5]); w.w = pk2(v[6], v[7]);
                        if (cb1 < 2048) { const int cc = col - cb1; *(u32x4*)(base1 + qk_off(row, cc >> 7, (cc & 127) >> 3, cb1 ? swap23(row & 31) : (row & 31))) = w; }
                        else *(u32x4*)(base1 + (size_t)row * ld1 + (col - cb1)) = w;
                    } else if (MODE == 2) {
                        if (rt2 >= 2048 && rt2 < 3072) {
                            float lg[8];
                            _Pragma("unroll") for (int j = 0; j < 8; ++j) { const float xx = v[j]; const float ls = fminf(xx, 0.f) - __logf(1.f + __expf(-fabsf(xx)));
                                lg[j] = (lbv > 0.f) ? __logf(lbv + (1.f - lbv) * __expf(ls)) : ls; }
                            float* lp = (float*)(ws + R1_LOGFT) + fm32_off(row - 2048, col);
                            *(f32x4*)lp = (f32x4){lg[0], lg[1], lg[2], lg[3]}; *(f32x4*)(lp + 128) = (f32x4){lg[4], lg[5], lg[6], lg[7]};
                        } else {
                            bf16_t* b2; int rb;
                            if (rt2 < 1024) { b2 = (bf16_t*)(ws + R1_VT); rb = 0; } else if (rt2 < 2048) { b2 = (bf16_t*)(ws + R1_QQT); rb = 1024; _Pragma("unroll") for (int j = 0; j < 8; ++j) v[j] = silu_(v[j]); }
                            else { b2 = (bf16_t*)(ws + R1_VHT); rb = 3072; }
                            u32x4 w; w.x = pk2(v[0], v[1]); w.y = pk2(v[2], v[3]); w.z = pk2(v[4], v[5]); w.w = pk2(v[6], v[7]);
                            *(u32x4*)(b2 + fm16_off(row - rb, col)) = w;
                        }
                    } else if (MODE == 4) {
                        const u32x4 g = *(const u32x4*)((const bf16_t*)(ws + R5_SGB) + (size_t)row * D + col);
                        u32x4 w; w.x = pk2(v[0] * fmaxf(bflo(g.x), 1e-30f), v[1] * fmaxf(bfhi(g.x), 1e-30f)); w.y = pk2(v[2] * fmaxf(bflo(g.y), 1e-30f), v[3] * fmaxf(bfhi(g.y), 1e-30f));
                        w.z = pk2(v[4] * fmaxf(bflo(g.z), 1e-30f), v[5] * fmaxf(bfhi(g.z), 1e-30f)); w.w = pk2(v[6] * fmaxf(bflo(g.w), 1e-30f), v[7] * fmaxf(bfhi(g.w), 1e-30f));
                        *(u32x4*)((bf16_t*)(ws + R2_MERGED) + (size_t)row * D + col) = w;
                    } else if (MODE == 5) {
                        u32x4 w; w.x = pk2(v[0], v[1]); w.y = pk2(v[2], v[3]); w.z = pk2(v[4], v[5]); w.w = pk2(v[6], v[7]);
                        *(u32x4*)((bf16_t*)(ws + (lb ? R3_MLP : R3_MIX)) + (size_t)row * D + col) = w;
                    } else if (MODE == 6) {
                        _Pragma("unroll") for (int j = 0; j < 8; ++j) { const float r = fmaxf(v[j], 0.f); v[j] = r * r; }
                        u32x4 w; w.x = pk2(v[0], v[1]); w.y = pk2(v[2], v[3]); w.z = pk2(v[4], v[5]); w.w = pk2(v[6], v[7]);
                        *(u32x4*)((bf16_t*)(ws + R1_U) + (size_t)row * FF + col) = w;
                    }
                } }
    }
};

template <int MODE, int STAG = 0> __device__ __forceinline__ void run_gemm(LAS unsigned char* lds, const bf16_t* A, const bf16_t* Bt, int M_, int N_, int K_, unsigned char* ws, const float* lb, int wv) {
    if (STAG > 0) {
        const unsigned long long t0 = __builtin_amdgcn_s_memrealtime(); const unsigned long long dl = (unsigned long long)(((blockIdx.x >> 3) & 7) * STAG);
        while (__builtin_amdgcn_s_memrealtime() - t0 < dl) __builtin_amdgcn_s_sleep(4); }
    pg8::Gemm g{A, Bt, M_, N_, K_}; WvOrder S; S.init(M_, N_, (int)gridDim.x, (int)blockIdx.x); S.wv = wv; S.rot = 0; if (MODE == 2) { S.wgm = G2WGM; S.rot = 4; }
    Epi<MODE> E{ws, lb};
    pg8::gemm_phase<Epi<MODE>, WvOrder, false>(lds, g, S, E, nullptr);
}

struct PrepItem { const float* src; bf16_t* dst; int K, N, remap, ldk, koff, tn, tk; };
__device__ __forceinline__ PrepItem prep_item(const Params& p, bf16_t* Wb, int layer, int t4) {
    PrepItem q; int tt = t4 * 4; q.remap = 0; q.ldk = 0; q.koff = 0;
    if (tt < 5632) { q.src = p.w_in + (size_t)layer * 2048 * 11264; q.dst = Wb + W_IN; q.K = 2048; q.N = 11264; q.remap = 1; }
    else if ((tt -= 5632) < 512) { q.src = p.w_sb + (size_t)layer * 1024 * 2048; q.dst = Wb + W_SB; q.K = 1024; q.N = 2048; q.ldk = 2048; }
    else if ((tt -= 512) < 512) { q.src = p.w_hg + (size_t)layer * 1024 * 2048; q.dst = Wb + W_SB; q.K = 1024; q.N = 2048; q.ldk = 2048; q.koff = 1024; }
    else if ((tt -= 512) < 1024) { q.src = p.w_out + (size_t)layer * 2048 * 2048; q.dst = Wb + W_OUT; q.K = 2048; q.N = 2048; }
    else if ((tt -= 1024) < 4096) { q.src = p.w_up + (size_t)layer * 2048 * 8192; q.dst = Wb + W_UP; q.K = 2048; q.N = 8192; }
    else { tt -= 4096; q.src = p.w_dn + (size_t)layer * 8192 * 2048; q.dst = Wb + W_DN; q.K = 8192; q.N = 2048; }
    const int nk = q.K / 64; q.tn = tt / nk; q.tk = tt % nk;
    return q;
}
__device__ void prep_weights(const Params& p, int layer, float* tile, int wv) {
    const int tid = ltid(wv);
    bf16_t* Wb = (bf16_t*)(p.ws + WS_W);
    int t4 = blockIdx.x;
    if (t4 >= 3968) return;
    PrepItem q = prep_item(p, Wb, layer, t4);
    f32x4 v[8];
#pragma unroll
    for (int i = 0; i < 8; ++i) { const int idx = tid + i * 512, r = idx >> 4, c4 = (idx & 15) * 4; v[i] = *(const f32x4*)(q.src + (size_t)(q.tk * 64 + r) * q.N + q.tn * 64 + c4); }
    for (;;) {
#pragma unroll
        for (int i = 0; i < 8; ++i) { const int idx = tid + i * 512, r = idx >> 4, c4 = (idx & 15) * 4;
            tile[r * 65 + c4] = v[i][0]; tile[r * 65 + c4 + 1] = v[i][1]; tile[r * 65 + c4 + 2] = v[i][2]; tile[r * 65 + c4 + 3] = v[i][3]; }
        __syncthreads();
        const int t4n = t4 + (int)gridDim.x; const bool more = t4n < 3968;
        PrepItem qn = q;
        if (more) { qn = prep_item(p, Wb, layer, t4n);
#pragma unroll
            for (int i = 0; i < 8; ++i) { const int idx = tid + i * 512, r = idx >> 4, c4 = (idx & 15) * 4; v[i] = *(const f32x4*)(qn.src + (size_t)(qn.tk * 64 + r) * qn.N + qn.tn * 64 + c4); } }
        { const int n = tid & 63, kq = tid >> 6;
            int drow = q.tn * 64 + n;
            if (q.remap) { if (drow >= 6144) drow = 2048 + (drow - 6144); else if (drow >= 2048) drow = 7168 + (drow - 2048); }
            bf16_t* dp = q.dst + (size_t)drow * (q.ldk ? q.ldk : q.K) + q.koff + q.tk * 64 + kq * 32;
#pragma unroll
            for (int qq = 0; qq < 4; ++qq) { float f[8];
#pragma unroll
                for (int j = 0; j < 8; ++j) f[j] = tile[(kq * 32 + qq * 8 + j) * 65 + n];
                u32x4 w; w.x = pk2(f[0], f[1]); w.y = pk2(f[2], f[3]); w.z = pk2(f[4], f[5]); w.w = pk2(f[6], f[7]);
                *(u32x4*)(dp + qq * 8) = w; } }
        __syncthreads();
        if (!more) break;
        q = qn; t4 = t4n;
    }
}

__device__ void ada_partials(const Params& p, float* sl, int wv) {
    const int tid = ltid(wv); float* part = (float*)(p.ws + WS_PART);
    for (int u = blockIdx.x; u < 768; u += gridDim.x) {
        const int jb = u % 24, s = (u / 24) % 16, l = u / 384;
        __syncthreads();
        { const int b = tid >> 7, k = tid & 127; sl[tid] = silu_(p.c[b * D + s * 128 + k]); }
        __syncthreads();
        const int j = jb * 512 + tid;
        const float* w = p.w_ada + ((size_t)l * D + s * 128) * NADA + j;
        float a0 = 0.f, a1 = 0.f, a2 = 0.f, a3 = 0.f;
#pragma unroll 1
        for (int k0 = 0; k0 < 128; k0 += 16) { float wv[16];
#pragma unroll
            for (int k = 0; k < 16; ++k) wv[k] = w[(size_t)(k0 + k) * NADA];
#pragma unroll
            for (int k = 0; k < 16; ++k) { a0 += wv[k] * sl[k0 + k]; a1 += wv[k] * sl[128 + k0 + k]; a2 += wv[k] * sl[256 + k0 + k]; a3 += wv[k] * sl[384 + k0 + k]; } }
        float* po = part + (size_t)((s * 2 + l) * 4) * NADA + j;
        po[0] = a0; po[NADA] = a1; po[2 * NADA] = a2; po[3 * NADA] = a3;
    }
}

__device__ void cond_finalize(const Params& p, int wv) {
    const int gt = blockIdx.x * NTHR + ltid(wv), nt = gridDim.x * NTHR;
    const float* part = (const float*)(p.ws + WS_PART); float* cond = (float*)(p.ws + WS_COND); float* lb = (float*)(p.ws + WS_LB);
    for (int i = gt; i < 2 * 4 * NADA; i += nt) { const int l = i / (4 * NADA), rem = i % (4 * NADA), b = rem / NADA, j = rem % NADA;
        float a = p.b_ada[l * NADA + j];
#pragma unroll
        for (int s = 0; s < 16; ++s) a += part[(size_t)((s * 2 + l) * 4 + b) * NADA + j];
        cond[i] = a; }
    for (int i = gt; i < 2048; i += nt) { const int l = i >> 10, j = i & 1023;
        lb[i] = (l == 0) ? 0.f : 1.f / (1.f + __expf(p.lb_logits[j] - p.lb_logits[1024 + j])); }
}

__device__ __forceinline__ void rp_branch(f32x4 (&v)[8], const bf16_t* mbuf, const float* gp_, const float* gt_, int row, size_t cb, int lane) {
    f32x4 m[8]; float ss = 0.f;
#pragma unroll
    for (int i = 0; i < 8; ++i) { const u32x2 mw = *(const u32x2*)(mbuf + (size_t)row * D + 4 * lane + 256 * i); m[i] = (f32x4){bflo(mw.x), bfhi(mw.x), bflo(mw.y), bfhi(mw.y)}; ss += m[i][0] * m[i][0] + m[i][1] * m[i][1] + m[i][2] * m[i][2] + m[i][3] * m[i][3]; }
#pragma unroll
    for (int o = 32; o >= 1; o >>= 1) ss += shfl_xor_l(ss, lane, o);
    const float rs = rsqrtf(ss * (1.f / D) + EPS);
#pragma unroll
    for (int i = 0; i < 8; ++i) { const int c = 4 * lane + 256 * i;
        const f32x4 gp = *(const f32x4*)(gp_ + c), gg = *(const f32x4*)(gt_ + cb + c);
        v[i] = v[i] + gg * (m[i] * rs * gp); }
}
template <int KIND> __device__ void rowpass(const float* xres, const bf16_t* mix, const bf16_t* mlp, float* xout, bf16_t* hout, const float* gp1, const float* gt1, const float* gp2, const float* gt2,
                                            const float* gpre, const float* sc_, const float* sh_, int wv) {
    const int tid = ltid(wv), lane = tid & 63, wave = tid >> 6;
    const int nw = gridDim.x * 8;
    for (int row = blockIdx.x * 8 + wave; row < M; row += nw) {
        const int b = row >> 12; const size_t cb = (size_t)b * NADA;
        f32x4 v[8];
#pragma unroll
        for (int i = 0; i < 8; ++i) v[i] = *(const f32x4*)(xres + (size_t)row * D + 4 * lane + 256 * i);
        if (KIND >= 1) rp_branch(v, mix, gp1, gt1, row, cb, lane);
        if (KIND >= 2) { rp_branch(v, mlp, gp2, gt2, row, cb, lane);
#pragma unroll
            for (int i = 0; i < 8; ++i) *(f32x4*)(xout + (size_t)row * D + 4 * lane + 256 * i) = v[i]; }
        if (KIND != 2) {
            float ss = 0.f;
#pragma unroll
            for (int i = 0; i < 8; ++i) ss += v[i][0] * v[i][0] + v[i][1] * v[i][1] + v[i][2] * v[i][2] + v[i][3] * v[i][3];
#pragma unroll
            for (int o = 32; o >= 1; o >>= 1) ss += shfl_xor_l(ss, lane, o);
            const float rs = rsqrtf(ss * (1.f / D) + EPS);
#pragma unroll
            for (int i = 0; i < 8; ++i) { const int c = 4 * lane + 256 * i;
                const f32x4 gp = *(const f32x4*)(gpre + c), sc = *(const f32x4*)(sc_ + cb + c), sh = *(const f32x4*)(sh_ + cb + c);
                const f32x4 hh = (v[i] * rs * gp) * (1.f + sc) + sh;
                u32x2 w; w.x = pk2(hh[0], hh[1]); w.y = pk2(hh[2], hh[3]);
                *(u32x2*)(hout + (size_t)row * D + c) = w; }
        }
    }
}

template <bool DIAG> __device__ __forceinline__ void attn_tile(const bf16_t* Kb, const bf16_t* VT, const bf16x8 (&qf)[8], bf16x8 (&kf)[8], f32x16 (&o)[4], float& carry,
                                                              int tb, int s0, int hd, int tq, int h, int sg, bool more) {
    const float scale = 0.08838834764831845f * 1.4426950408889634f;
    f32x16 z = zero16();
#pragma unroll
    for (int c = 0; c < 8; ++c) z = MFMA32(kf[c], qf[c], z);
    bf16x8 vf[4][2];
#pragma unroll
    for (int e = 0; e < 4; ++e)
#pragma unroll
        for (int c2 = 0; c2 < 2; ++c2) vf[e][c2] = *(const bf16x8*)(VT + fm16_off(hd * 128 + 32 * e + tq, tb + s0 + 16 * c2 + 8 * h));
    if (more) { const bf16_t* kp = Kb + qk_off(tb + s0 - 32, hd, h, tq);
#pragma unroll
        for (int c = 0; c < 8; ++c) kf[c] = *(const bf16x8*)(kp + 512 * c); }
    float L[16];
#pragma unroll
    for (int i = 0; i < 16; ++i) { const int kl = 16 * (i >> 3) + 8 * h + (i & 7);
        const float zz = z[i] * scale; const float sp = fmaxf(zz, 0.f) + __builtin_amdgcn_logf(1.f + __builtin_amdgcn_exp2f(-fabsf(zz)));
        const bool valid = !DIAG || (kl < tq);
        L[i] = valid ? -sp : 0.f; z[i] = valid ? (zz - sp) : -1e30f; }
    float a = 0.f, bs = 0.f;
#pragma unroll
    for (int i = 0; i < 8; ++i) { a += L[i]; bs += L[8 + i]; }
    const float a2 = shfl_xor_l(a, tq | (h << 5), 32), b2 = shfl_xor_l(bs, tq | (h << 5), 32);
    float run = carry + bs + b2 + (h == 0 ? a2 : 0.f);
#pragma unroll
    for (int i = 7; i >= 0; --i) { z[i] = __builtin_amdgcn_exp2f(z[i] + run); run += L[i]; }
    run = carry + (h == 0 ? b2 : 0.f);
#pragma unroll
    for (int i = 15; i >= 8; --i) { z[i] = __builtin_amdgcn_exp2f(z[i] + run); run += L[i]; }
    carry += (a + a2) + (bs + b2);
    bf16x8 pf[2];
#pragma unroll
    for (int c2 = 0; c2 < 2; ++c2) { u32x4 w; w.x = pk2(z[8 * c2], z[8 * c2 + 1]); w.y = pk2(z[8 * c2 + 2], z[8 * c2 + 3]); w.z = pk2(z[8 * c2 + 4], z[8 * c2 + 5]); w.w = pk2(z[8 * c2 + 6], z[8 * c2 + 7]);
        pf[c2] = __builtin_bit_cast(bf16x8, w); }
#pragma unroll
    for (int e = 0; e < 4; ++e)
#pragma unroll
        for (int c2 = 0; c2 < 2; ++c2) o[e] = MFMA32(vf[e][c2], pf[c2], o[e]);
}

__device__ __forceinline__ void attn_item(const bf16_t* Q, const bf16_t* Kb, const bf16_t* VT, bf16_t* Y, int item, int lane) {
    const int qt = 127 - (item & 127), hd = (item >> 7) & 7, b = item >> 10;
    const int tq = lane & 31, h = lane >> 5;
    const int tb = b * T; const int t0 = qt * 32;
    const bf16_t* qp = Q + qk_off(tb + t0, hd, h, tq);
    bf16x8 qf[8];
#pragma unroll
    for (int c = 0; c < 8; ++c) qf[c] = *(const bf16x8*)(qp + 512 * c);
    f32x16 o[4];
#pragma unroll
    for (int e = 0; e < 4; ++e) o[e] = zero16();
    float carry = 0.f;
    const int sg = (tq & 19) | ((tq & 4) << 1) | ((tq & 8) >> 1);
    bf16x8 kf[8];
    { const bf16_t* kp = Kb + qk_off(tb + t0, hd, h, tq);
#pragma unroll
      for (int c = 0; c < 8; ++c) kf[c] = *(const bf16x8*)(kp + 512 * c); }
    attn_tile<true>(Kb, VT, qf, kf, o, carry, tb, t0, hd, tq, h, sg, qt > 0);
    for (int kt = qt - 1; kt >= 0; --kt) {
        if (__all(carry < -150.1f)) break;
        attn_tile<false>(Kb, VT, qf, kf, o, carry, tb, kt * 32, hd, tq, h, sg, kt > 0);
    }
    bf16_t* yp = Y + (unsigned)((tb + t0 + tq) * 2048 + hd * 128 + 4 * h);
#pragma unroll
    for (int e = 0; e < 4; ++e)
#pragma unroll
        for (int g = 0; g < 4; ++g) { u32x2 w; w.x = pk2(o[e][4 * g], o[e][4 * g + 1]); w.y = pk2(o[e][4 * g + 2], o[e][4 * g + 3]); *(u32x2*)(yp + 32 * e + 8 * g) = w; }
}

__device__ __forceinline__ void hg1_item(unsigned char* ws, LAS unsigned char* wl, int item, int lane) {
    const float* LOGFT = (const float*)(ws + R1_LOGFT); const bf16_t* QQT = (const bf16_t*)(ws + R1_QQT); const bf16_t* VHT = (const bf16_t*)(ws + R1_VHT);
    bf16_t* QG = (bf16_t*)(ws + R2_QG); bf16_t* KG = (bf16_t*)(ws + R2_KG); float* DEC = (float*)(ws + WS_DEC); bf16_t* ST = (bf16_t*)(ws + R3_ST);
    const int db = item & 3, ch = item >> 2;
    const int n = ch & 63, hd = (ch >> 6) & 7, b = ch >> 9;
    const int d = lane & 31, h = lane >> 5;
    const int f = hd * 128 + db * 32 + d;
    const int tk = b * T + n * 64;
    float G[64];
#pragma unroll
    for (int tt = 0; tt < 2; ++tt) { const float* lp = LOGFT + fm32_off(f, tk + 32 * tt);
#pragma unroll
        for (int i = 0; i < 8; ++i) { const f32x4 v = *(const f32x4*)(lp + 128 * i); G[32 * tt + 4 * i] = v[0]; G[32 * tt + 4 * i + 1] = v[1]; G[32 * tt + 4 * i + 2] = v[2]; G[32 * tt + 4 * i + 3] = v[3]; } }
    u32x4 qw[8];
#pragma unroll
    for (int tt = 0; tt < 2; ++tt)
#pragma unroll
        for (int i = 0; i < 4; ++i) qw[4 * tt + i] = *(const u32x4*)(QQT + fm16_off(f, tk + 32 * tt) + 256 * i);
    float ko[32];
#pragma unroll
    for (int c = 0; c < 4; ++c)
#pragma unroll
        for (int j = 0; j < 8; ++j) ko[8 * c + j] = 1.f - __builtin_amdgcn_exp2f((h ? G[16 * c + 8 + j] : G[16 * c + j]) * 1.4426950408889634f);
#pragma unroll
    for (int t = 1; t < 64; ++t) G[t] += G[t - 1];
    const float Gl2 = G[63] * 1.4426950408889634f;
    if (h == 0) DEC[(size_t)ch * 128 + db * 32 + d] = __builtin_amdgcn_exp2f(Gl2);
    bf16x8 af[4];
#pragma unroll
    for (int c = 0; c < 4; ++c) { float kdv[8];
#pragma unroll
        for (int j = 0; j < 8; ++j) {
            const float g2 = (h ? G[16 * c + 8 + j] : G[16 * c + j]) * 1.4426950408889634f;
            const unsigned qwv = h ? qw[2 * c + 1][j >> 1] : qw[2 * c][j >> 1];
            const float kk = ko[8 * c + j], qq = (j & 1) ? bfhi(qwv) : bflo(qwv);
            const float qg = qq * __builtin_amdgcn_exp2f(g2), kg = kk * __builtin_amdgcn_exp2f(fminf(-g2, 120.f));
            kdv[j] = kk * __builtin_amdgcn_exp2f(Gl2 - g2);
            LAS unsigned char* wp = wl + (c >> 1) * 4096 + ((16 * (c & 1) + j) * 32 + d) * 2 + h * 512;
            *(LAS bf16_t*)wp = (bf16_t)(pk2(qg, 0.f) & 0xffffu); *(LAS bf16_t*)(wp + 2048) = (bf16_t)(pk2(kg, 0.f) & 0xffffu); }
        u32x4 w; w.x = pk2(kdv[0], kdv[1]); w.y = pk2(kdv[2], kdv[3]); w.z = pk2(kdv[4], kdv[5]); w.w = pk2(kdv[6], kdv[7]); af[c] = __builtin_bit_cast(bf16x8, w); }
    {
        const int tt_ = lane >> 1, hf = lane & 1;
        asm volatile("" ::: "memory");
#pragma unroll
        for (int tile = 0; tile < 2; ++tile)
#pragma unroll
            for (int j = 0; j < 2; ++j) {
                const u32x4 qv = *(const LAS u32x4*)(wl + tile * 4096 + lane * 32 + j * 16), kv = *(const LAS u32x4*)(wl + tile * 4096 + 2048 + lane * 32 + j * 16);
                const int piece = db * 4 + 2 * hf + j;
                *(u32x4*)(QG + qk_off(tk + 32 * tile, hd, piece, tt_)) = qv; *(u32x4*)(KG + qk_off(tk + 32 * tile, hd, piece, swap23(tt_))) = kv; }
        asm volatile("" ::: "memory");
    }
#pragma unroll
    for (int e = 0; e < 4; ++e) { f32x16 acc = zero16();
        bf16x8 vf[4];
#pragma unroll
        for (int c = 0; c < 4; ++c) vf[c] = *(const bf16x8*)(VHT + fm16_off(hd * 128 + 32 * e + d, tk + 16 * c + 8 * h));
#pragma unroll
        for (int c = 0; c < 4; ++c) acc = MFMA32(af[c], vf[c], acc);
        bf16_t* sp = ST + (size_t)ch * 16384 + ((e * 16 + 4 * db) * 32 + d) * 8 + 4 * h;
#pragma unroll
        for (int g = 0; g < 4; ++g) { u32x2 w; w.x = pk2(acc[4 * g], acc[4 * g + 1]); w.y = pk2(acc[4 * g + 2], acc[4 * g + 3]); *(u32x2*)(sp + 256 * g) = w; } }
}

__device__ void hg2_scan(unsigned char* ws, int wv) {
    bf16_t* ST = (bf16_t*)(ws + R3_ST); const float* DEC = (const float*)(ws + WS_DEC);
    const int gt = blockIdx.x * NTHR + ltid(wv), nt = gridDim.x * NTHR;
    for (int i = gt; i < 32 * 128 * 32; i += nt) {
        const int gi = i & 4095, bh = i >> 12;
        const int d0 = ((gi >> 6) & 15) * 8 + (gi & 1) * 4;
        float s0 = 0.f, s1 = 0.f, s2 = 0.f, s3 = 0.f;
        bf16_t* sp = ST + (size_t)bh * 64 * 16384 + 4 * gi;
        const float* dp = DEC + (size_t)bh * 64 * 128 + d0;
        u32x2 wb[16]; f32x4 db[16];
#pragma unroll
        for (int k = 0; k < 16; ++k) { wb[k] = *(const u32x2*)(sp + (size_t)k * 16384); db[k] = *(const f32x4*)(dp + k * 128); }
#pragma unroll 1
        for (int n0 = 0; n0 < 64; n0 += 16) {
#pragma unroll
            for (int k = 0; k < 16; ++k) { const int n = n0 + k;
                const u32x2 w = wb[k]; const f32x4 dc = db[k];
                if (n0 + 16 < 64) { wb[k] = *(const u32x2*)(sp + (size_t)(n + 16) * 16384); db[k] = *(const f32x4*)(dp + (n + 16) * 128); }
                u32x2 o; o.x = pk2(s0, s1); o.y = pk2(s2, s3); *(u32x2*)(sp + (size_t)n * 16384) = o;
                s0 = dc[0] * s0 + bflo(w.x); s1 = dc[1] * s1 + bfhi(w.x); s2 = dc[2] * s2 + bflo(w.y); s3 = dc[3] * s3 + bfhi(w.y); }
        }
    }
}

__device__ __forceinline__ void hg3_item(unsigned char* ws, const float* ghg, int item, int lane) {
    const bf16_t* QG = (const bf16_t*)(ws + R2_QG); const bf16_t* KG = (const bf16_t*)(ws + R2_KG); const bf16_t* VHT = (const bf16_t*)(ws + R1_VHT);
    const bf16_t* ST = (const bf16_t*)(ws + R3_ST); const bf16_t* SHG = (const bf16_t*)(ws + R4_SHG); bf16_t* Y = (bf16_t*)(ws + HB_YHG);
    const int th = item & 1, ch = item >> 1;
    const int n = ch & 63, hd = (ch >> 6) & 7, b = ch >> 9;
    const int tq = lane & 31, h = lane >> 5;
    const int tk = b * T + n * 64;
    const bf16_t* qp = QG + qk_off(tk + 32 * th, hd, h, tq);
    bf16x8 qf[8];
#pragma unroll
    for (int c = 0; c < 8; ++c) qf[c] = *(const bf16x8*)(qp + 512 * c);
    f32x16 o[4];
#pragma unroll
    for (int e = 0; e < 4; ++e) o[e] = zero16();
    for (int st = 0; st <= th; ++st) {
        const bf16_t* kp = KG + qk_off(tk + 32 * st, hd, h, tq);
        f32x16 z = zero16();
#pragma unroll
        for (int c = 0; c < 8; ++c) z = MFMA32(*(const bf16x8*)(kp + 512 * c), qf[c], z);
        const bool diag = (st == th);
        bf16x8 pf[2];
#pragma unroll
        for (int c2 = 0; c2 < 2; ++c2) { float s[8];
#pragma unroll
            for (int j = 0; j < 8; ++j) { const int kl = 16 * c2 + 8 * h + j; s[j] = (!diag || kl <= tq) ? z[8 * c2 + j] : 0.f; }
            u32x4 w; w.x = pk2(s[0], s[1]); w.y = pk2(s[2], s[3]); w.z = pk2(s[4], s[5]); w.w = pk2(s[6], s[7]); pf[c2] = __builtin_bit_cast(bf16x8, w); }
#pragma unroll
        for (int e = 0; e < 4; ++e)
#pragma unroll
            for (int c2 = 0; c2 < 2; ++c2) o[e] = MFMA32(*(const bf16x8*)(VHT + fm16_off(hd * 128 + 32 * e + tq, tk + 32 * st + 16 * c2 + 8 * h)), pf[c2], o[e]);
    }
#pragma unroll
    for (int e = 0; e < 4; ++e) {
        const bf16_t* sp = ST + (size_t)ch * 16384 + ((e * 16 + h) * 32 + tq) * 8;
#pragma unroll
        for (int c = 0; c < 8; ++c) o[e] = MFMA32(*(const bf16x8*)(sp + 512 * c), qf[c], o[e]); }
    float ss = 0.f;
#pragma unroll
    for (int e = 0; e < 4; ++e)
#pragma unroll
        for (int i = 0; i < 16; ++i) ss += o[e][i] * o[e][i];
    ss += shfl_xor_l(ss, lane, 32);
    const float rs = rsqrtf(ss * (1.f / 128.f) + EPS);
    const size_t tokr = (size_t)(tk + 32 * th + tq);
#pragma unroll
    for (int e = 0; e < 4; ++e)
#pragma unroll
        for (int g = 0; g < 4; ++g) { const int e0 = 32 * e + 8 * g;
            const f32x4 gn = *(const f32x4*)(ghg + hd * 128 + 4 * h + e0); const u32x2 gw = *(const u32x2*)(SHG + tokr * 1024 + hd * 128 + 4 * h + e0);
            u32x2 w; w.x = pk2(o[e][4 * g] * rs * gn[0] * bflo(gw.x), o[e][4 * g + 1] * rs * gn[1] * bfhi(gw.x));
            w.y = pk2(o[e][4 * g + 2] * rs * gn[2] * bflo(gw.y), o[e][4 * g + 3] * rs * gn[3] * bfhi(gw.y));
            *(u32x2*)(Y + 2 * tokr * 1024 + hd * 128 + 4 * h + e0) = w; }
}

__global__ void __launch_bounds__(NTHR, 2) fwd_kernel(Params p) {
    extern __shared__ __attribute__((aligned(16))) unsigned char lds_raw[];
    LAS unsigned char* lds = (LAS unsigned char*)lds_raw;
    float* ldsf = (float*)lds_raw;
    cg::grid_group grid = cg::this_grid();
    unsigned char* ws = p.ws;
    const int nw = gridDim.x * 8;
    bf16_t* Wb = (bf16_t*)(ws + WS_W); bf16_t* HB = (bf16_t*)(ws + WS_HB);
    const float* cond = (const float*)(ws + WS_COND);
    unsigned* bar = (unsigned*)(ws + WS_BAR); volatile LAS unsigned* bst = (volatile LAS unsigned*)(lds + LDS_BYTES);

    const int wv = __builtin_amdgcn_readfirstlane(threadIdx.x >> 6);
    if (threadIdx.x == 0) { bst[0] = 0u; bst[1] = 0u; (void)xb_add(&bar[XB_XCNT(xb_xcc_id())], 1u); }
    __syncthreads();
    prep_weights(p, 0, ldsf, wv);
    ada_partials(p, ldsf, wv);
    if (p.ws == nullptr) grid.sync();
    grid_bar(bar, bst, wv);
    cond_finalize(p, wv);
    grid_bar(bar, bst, wv);
    rowpass<0>(p.x, nullptr, nullptr, nullptr, HB, nullptr, nullptr, nullptr, nullptr, p.g_pre_mix, cond + 2048, cond, wv);
    grid_bar(bar, bst, wv);
#pragma clang loop unroll(disable)
    for (int l = 0; l < 2; ++l) {
        const float* condl = cond + (size_t)l * 4 * NADA;
        run_gemm<1, GSTAG>(lds, HB, Wb + W_IN, M, NG1, D, ws, nullptr, wv);
        run_gemm<2>(lds, Wb + W_IN + (size_t)NG1 * D, HB, NG2, M, D, ws, (const float*)(ws + WS_LB) + l * 1024, wv);
        grid_bar(bar, bst, wv);
        { const int tid = ltid(wv), lane = tid & 63, gw = blockIdx.x * 8 + (tid >> 6);
          for (int it = gw; it < 4096; it += nw) attn_item((const bf16_t*)(ws + R1_Q), (const bf16_t*)(ws + R1_K), (const bf16_t*)(ws + R1_VT), (bf16_t*)(ws + HB_YSB), it, lane); }
        { const int tid = ltid(wv), lane = tid & 63, gw = blockIdx.x * 8 + (tid >> 6);
          LAS unsigned char* wl = lds + (tid >> 6) * 8192;
          for (int it = gw; it < 8192; it += nw) hg1_item(ws, wl, it, lane); }
        grid_bar(bar, bst, wv);
        hg2_scan(ws, wv);
        grid_bar(bar, bst, wv);
        { const int tid = ltid(wv), lane = tid & 63, gw = blockIdx.x * 8 + (tid >> 6);
        for (int it = gw; it < 4096; it += nw) hg3_item(ws, p.g_hg + l * 1024, it, lane); }
        grid_bar(bar, bst, wv);
        run_gemm<4, GSTAG>(lds, HB, Wb + W_SB, M, D, D, ws, nullptr, wv);
        grid_bar(bar, bst, wv);
        run_gemm<5, GSTAG>(lds, (const bf16_t*)(ws + R2_MERGED), Wb + W_OUT, M, D, D, ws, nullptr, wv);
        grid_bar(bar, bst, wv);
        rowpass<1>(l == 0 ? p.x : p.out, (const bf16_t*)(ws + R3_MIX), nullptr, nullptr, HB, p.g_post_mix + l * D, condl + 2 * D, nullptr, nullptr, p.g_pre_mlp + l * D, condl + 4 * D, condl + 3 * D, wv);
        grid_bar(bar, bst, wv);
        run_gemm<6, GSTAG>(lds, HB, Wb + W_UP, M, FF, D, ws, nullptr, wv);
        grid_bar(bar, bst, wv);
        run_gemm<5, GSTAG>(lds, (const bf16_t*)(ws + R1_U), Wb + W_DN, M, D, FF, ws, (const float*)ws  , wv);
        grid_bar(bar, bst, wv);
        if (l == 0) {
            const float* cond1 = cond + (size_t)4 * NADA;
            rowpass<3>(p.x, (const bf16_t*)(ws + R3_MIX), (const bf16_t*)(ws + R3_MLP), p.out, HB, p.g_post_mix, condl + 2 * D, p.g_post_mlp, condl + 5 * D, p.g_pre_mix + D, cond1 + D, cond1, wv);
            prep_weights(p, 1, ldsf, wv);
            grid_bar(bar, bst, wv);
        } else {
            rowpass<2>(p.out, (const bf16_t*)(ws + R3_MIX), (const bf16_t*)(ws + R3_MLP), p.out, nullptr, p.g_post_mix + D, condl + 2 * D, p.g_post_mlp + D, condl + 5 * D, nullptr, nullptr, nullptr, wv);
        }
    }
}

extern "C" void kernel_launch(void* const* d_in, const int* in_sizes, int n_in, void* d_out, int out_size, void* d_ws, size_t ws_size, hipStream_t stream) {
    static int grid = 0;
    if (grid == 0) {
        if (n_in != 16 || out_size != M * D || ws_size < WS_END) { fprintf(stderr, "kernel_launch: unexpected shapes: n_in %d out %d ws %zu (need %zu)\n", n_in, out_size, ws_size, (size_t)WS_END); grid = -1; return; }
        int dev = 0, cus = 0, per_cu = 0;
        hipGetDevice(&dev); hipDeviceGetAttribute(&cus, hipDeviceAttributeMultiprocessorCount, dev);
        if (hipFuncSetAttribute((const void*)fwd_kernel, hipFuncAttributeMaxDynamicSharedMemorySize, LDS_BYTES + 64) != hipSuccess) { fprintf(stderr, "kernel_launch: hipFuncSetAttribute failed\n"); grid = -1; return; }
        hipOccupancyMaxActiveBlocksPerMultiprocessor(&per_cu, (const void*)fwd_kernel, NTHR, LDS_BYTES + 64);
        (void)hipGetLastError();
        if (per_cu < 1) { fprintf(stderr, "kernel_launch: occupancy query says %d blocks per CU\n", per_cu); per_cu = 1; }
        grid = cus;
    }
    if (grid < 0) return;
    Params p{};
    p.x = (const float*)d_in[0]; p.c = (const float*)d_in[1]; p.w_ada = (const float*)d_in[2]; p.b_ada = (const float*)d_in[3]; p.g_pre_mix = (const float*)d_in[4]; p.g_post_mix = (const float*)d_in[5];
    p.w_in = (const float*)d_in[6]; p.lb_logits = (const float*)d_in[7]; p.g_hg = (const float*)d_in[8]; p.w_sb = (const float*)d_in[9]; p.w_hg = (const float*)d_in[10]; p.w_out = (const float*)d_in[11];
    p.g_pre_mlp = (const float*)d_in[12]; p.g_post_mlp = (const float*)d_in[13]; p.w_up = (const float*)d_in[14]; p.w_dn = (const float*)d_in[15];
    p.out = (float*)d_out; p.ws = (unsigned char*)d_ws;
    if (hipMemsetAsync((char*)d_ws + WS_BAR, 0, XCD_BAR_WORDS * 4, stream) != hipSuccess) { fprintf(stderr, "kernel_launch: memset failed\n"); return; }
    void* args[] = {&p};
    hipError_t e = hipLaunchCooperativeKernel((const void*)fwd_kernel, dim3(grid), dim3(NTHR), args, LDS_BYTES + 64, stream);
    if (e != hipSuccess) fprintf(stderr, "kernel_launch: cooperative launch failed: %s (grid %d)\n", hipGetErrorString(e), grid);
}
```
